# Optimizing an MI355X kernel written in HIP

```python
import math
import jax, jax.numpy as jnp
from jax import lax
import numpy as np

D_MODEL = 1024
BATCH = 2
SEQ = 8192
DEPTH = 1

GRID_W = 64
CTX_LEN = 256
D_SSM = D_MODEL // 2
SSM_GROUP_CH = 16
SSM_GROUPS = D_SSM // SSM_GROUP_CH
SSM_STATE = 64
D_POOL = D_MODEL // 2
POOL_WINDOWS = (2, 4, 8, 16)
POOL_GROUP_CH = D_POOL // len(POOL_WINDOWS)
FFN_HIDDEN = ((8 * D_MODEL // 3 + 255) // 256) * 256
RMS_EPS = 1e-6
DT_MIN = 1e-3
DT_MAX = 1e-1

kernel_name = "hybrid_s5_pool_prefix_dit_block"


def rms_norm(x, g):
    x32 = x.astype(jnp.float32)
    y = x32 * lax.rsqrt(jnp.mean(x32 * x32, axis=-1, keepdims=True) + RMS_EPS)
    return (y * g.astype(jnp.float32)).astype(x.dtype)


def modulate(h, shift, scale):
    return h * (1.0 + scale) + shift


def s5_discretize(a_re, a_im, log_dt, b_re, b_im):
    A = lax.complex(a_re.astype(jnp.float32), a_im.astype(jnp.float32))
    dt = jnp.exp(log_dt.astype(jnp.float32))[:, None]
    a_bar = jnp.exp(A * dt)
    B = lax.complex(b_re.astype(jnp.float32), b_im.astype(jnp.float32))
    b_bar = ((a_bar - 1.0) / A)[..., None] * B
    return a_bar, b_bar


def _lin_rec(e1, e2):
    a1, b1 = e1
    a2, b2 = e2
    return a1 * a2, a2 * b1 + b2


def s5_states(u, a_bar, b_bar, s0, reverse):
    bsz, length, _ = u.shape
    ug = u.astype(jnp.float32).reshape(bsz, length, SSM_GROUPS, SSM_GROUP_CH).astype(jnp.complex64)
    bu = jnp.einsum('gpc,blgc->blgp', b_bar, ug)
    if s0 is not None:
        idx = length - 1 if reverse else 0
        bu = bu.at[:, idx].add(a_bar[None] * s0)
    a = jnp.broadcast_to(a_bar, (1, length) + a_bar.shape)
    _, states = lax.associative_scan(_lin_rec, (a, bu), reverse=reverse, axis=1)
    return states


def s5_readout(u_a, st_f, st_b, c_f, c_b, d_skip, w_glu, b_glu):
    bsz, length, _ = u_a.shape
    y = (jnp.einsum('gcp,blgp->blgc', c_f, st_f) + jnp.einsum('gcp,blgp->blgc', c_b, st_b)).real
    y = y.reshape(bsz, length, D_SSM) + d_skip.astype(jnp.float32) * u_a.astype(jnp.float32)
    y = jax.nn.gelu(y)
    return y * jax.nn.sigmoid(y @ w_glu.astype(jnp.float32) + b_glu.astype(jnp.float32))


def pool_mixer(u, pool_w, pool_scale):
    width = u.shape[2]
    pos = jnp.arange(width)
    u32 = u.astype(jnp.float32)
    cs = jnp.pad(jnp.cumsum(u32, axis=2), ((0, 0), (0, 0), (1, 0), (0, 0)))
    outs = []
    for j, w in enumerate(POOL_WINDOWS):
        sl = slice(j * POOL_GROUP_CH, (j + 1) * POOL_GROUP_CH)
        lo = jnp.clip(pos - w // 2, 0, width - 1)
        hi = jnp.clip(pos + w - 1 - w // 2, 0, width - 1) + 1
        csg = cs[..., sl]
        mean = (csg[:, :, hi] - csg[:, :, lo]) / (hi - lo).astype(jnp.float32)[:, None]
        outs.append((mean - u32[..., sl]) @ pool_w[j].astype(jnp.float32))
    return jnp.concatenate(outs, axis=-1) * pool_scale.astype(jnp.float32)


def hybrid_mixer(proj, st_f, st_b, rows, width, c_f, c_b, s5_d, w_glu, b_glu, pool_w, pool_scale,
                 w_branch_a, w_branch_b, w_out):
    bsz, length, _ = proj.shape
    u_a, u_b, gate_a, gate_b = jnp.split(proj, [D_SSM, D_SSM + D_POOL, D_SSM + D_POOL + D_MODEL], axis=-1)
    y_a = s5_readout(u_a, st_f, st_b, c_f, c_b, s5_d, w_glu, b_glu) @ w_branch_a.astype(jnp.float32)
    y_b = pool_mixer(u_b.reshape(bsz, rows, width, D_POOL), pool_w, pool_scale).reshape(bsz, length, D_POOL)
    y_b = y_b @ w_branch_b.astype(jnp.float32)
    merged = jax.nn.sigmoid(gate_a.astype(jnp.float32)) * y_a + jax.nn.sigmoid(gate_b.astype(jnp.float32)) * y_b
    return (merged @ w_out.astype(jnp.float32)).astype(proj.dtype)


def swiglu(h, w_in, w_out):
    gate, up = jnp.split(h @ w_in, 2, axis=-1)
    return (jax.nn.silu(gate) * up) @ w_out


def setup_inputs(seed: int = 0) -> dict:
    key = jax.random.key(seed)
    ks = jax.random.split(key, 28)
    f32 = jnp.float32

    def nrm(k, shape, scale):
        return jax.random.normal(k, shape, f32) * scale

    G, P, CH = SSM_GROUPS, SSM_STATE, SSM_GROUP_CH
    n_idx = jnp.arange(P, dtype=f32)
    return {
        "x": nrm(ks[0], (BATCH, SEQ, D_MODEL), 1.0),
        "c": nrm(ks[1], (BATCH, D_MODEL), 1.0),
        "ctx": nrm(ks[2], (BATCH, CTX_LEN, D_MODEL), 1.0),
        "c_ctx": nrm(ks[3], (D_MODEL,), 1.0),
        "w_mod": nrm(ks[4], (DEPTH, D_MODEL, 6 * D_MODEL), 0.5 * D_MODEL ** -0.5),
        "b_mod": nrm(ks[5], (DEPTH, 6 * D_MODEL), 0.01),
        "norm1_g": 1.0 + nrm(ks[6], (DEPTH, D_MODEL), 0.05),
        "norm2_g": 1.0 + nrm(ks[7], (DEPTH, D_MODEL), 0.05),
        "w_in": nrm(ks[8], (DEPTH, D_MODEL, D_SSM + D_POOL + 2 * D_MODEL), D_MODEL ** -0.5),
        "s5_a_re": -0.5 + nrm(ks[9], (DEPTH, 2, G, P), 0.01),
        "s5_a_im": math.pi * n_idx + nrm(ks[10], (DEPTH, 2, G, P), 0.01),
        "s5_log_dt": jax.random.uniform(ks[11], (DEPTH, 2, G), f32, math.log(DT_MIN), math.log(DT_MAX)),
        "s5_b_re": nrm(ks[12], (DEPTH, 2, G, P, CH), (2 * CH) ** -0.5),
        "s5_b_im": nrm(ks[13], (DEPTH, 2, G, P, CH), (2 * CH) ** -0.5),
        "s5_c_re": nrm(ks[14], (DEPTH, 2, G, CH, P), (2 * P) ** -0.5),
        "s5_c_im": nrm(ks[15], (DEPTH, 2, G, CH, P), (2 * P) ** -0.5),
        "s5_d": nrm(ks[16], (DEPTH, D_SSM), 0.5),
        "w_glu": nrm(ks[17], (DEPTH, D_SSM, D_SSM), D_SSM ** -0.5),
        "b_glu": nrm(ks[18], (DEPTH, D_SSM), 0.01),
        "pool_w": nrm(ks[19], (DEPTH, len(POOL_WINDOWS), POOL_GROUP_CH, POOL_GROUP_CH), POOL_GROUP_CH ** -0.5),
        "pool_scale": 1.0 + nrm(ks[20], (DEPTH, D_POOL), 0.1),
        "w_branch_a": nrm(ks[21], (DEPTH, D_SSM, D_MODEL), D_SSM ** -0.5),
        "w_branch_b": nrm(ks[22], (DEPTH, D_POOL, D_MODEL), D_POOL ** -0.5),
        "w_out": nrm(ks[23], (DEPTH, D_MODEL, D_MODEL), D_MODEL ** -0.5),
        "w_ffn_in": nrm(ks[24], (DEPTH, D_MODEL, 2 * FFN_HIDDEN), D_MODEL ** -0.5),
        "w_ffn_out": nrm(ks[25], (DEPTH, FFN_HIDDEN, D_MODEL), FFN_HIDDEN ** -0.5),
        "final_norm_g": 1.0 + nrm(ks[26], (D_MODEL,), 0.05),
    }


def reference(x, c, ctx, c_ctx, w_mod, b_mod, norm1_g, norm2_g, w_in, s5_a_re, s5_a_im, s5_log_dt,
              s5_b_re, s5_b_im, s5_c_re, s5_c_im, s5_d, w_glu, b_glu, pool_w, pool_scale,
              w_branch_a, w_branch_b, w_out, w_ffn_in, w_ffn_out, final_norm_g):
    bsz, n_tok, _ = x.shape
    rows = n_tok // GRID_W
    ctx_len = ctx.shape[1]
    for i in range(DEPTH):
        last = i == DEPTH - 1
        mod_x = (jax.nn.silu(c) @ w_mod[i] + b_mod[i])[:, None, :]
        mod_c = (jax.nn.silu(c_ctx) @ w_mod[i] + b_mod[i])[None, None, :]
        sh1, sc1, g1, sh2, sc2, g2 = jnp.split(mod_x, 6, axis=-1)
        csh1, csc1, cg1, csh2, csc2, cg2 = jnp.split(mod_c, 6, axis=-1)

        h = modulate(rms_norm(x, norm1_g[i]), sh1, sc1)
        hc = modulate(rms_norm(ctx, norm1_g[i]), csh1, csc1)
        proj = h @ w_in[i]
        proj_c = hc @ (w_in[i][:, :D_SSM] if last else w_in[i])

        a_f, b_f = s5_discretize(s5_a_re[i, 0], s5_a_im[i, 0], s5_log_dt[i, 0], s5_b_re[i, 0], s5_b_im[i, 0])
        a_b, b_b = s5_discretize(s5_a_re[i, 1], s5_a_im[i, 1], s5_log_dt[i, 1], s5_b_re[i, 1], s5_b_im[i, 1])
        c_f = lax.complex(s5_c_re[i, 0].astype(jnp.float32), s5_c_im[i, 0].astype(jnp.float32))
        c_b = lax.complex(s5_c_re[i, 1].astype(jnp.float32), s5_c_im[i, 1].astype(jnp.float32))

        ua_c = proj_c[..., :D_SSM]
        st_cf = s5_states(ua_c, a_f, b_f, None, False)
        st_cb = s5_states(ua_c, a_b, b_b, None, True)
        st_f = s5_states(proj[..., :D_SSM], a_f, b_f, st_cf[:, -1], False)
        st_b = s5_states(proj[..., :D_SSM], a_b, b_b, st_cb[:, 0], True)

        mixed = hybrid_mixer(proj, st_f, st_b, rows, GRID_W, c_f, c_b, s5_d[i], w_glu[i], b_glu[i],
                             pool_w[i], pool_scale[i], w_branch_a[i], w_branch_b[i], w_out[i])
        x = x + g1 * mixed
        h2 = modulate(rms_norm(x, norm2_g[i]), sh2, sc2)
        x = x + g2 * swiglu(h2, w_ffn_in[i], w_ffn_out[i])

        if not last:
            mixed_c = hybrid_mixer(proj_c, st_cf, st_cb, 1, ctx_len, c_f, c_b, s5_d[i], w_glu[i], b_glu[i],
                                   pool_w[i], pool_scale[i], w_branch_a[i], w_branch_b[i], w_out[i])
            ctx = ctx + cg1 * mixed_c
            hc2 = modulate(rms_norm(ctx, norm2_g[i]), csh2, csc2)
            ctx = ctx + cg2 * swiglu(hc2, w_ffn_in[i], w_ffn_out[i])

    return rms_norm(x, final_norm_g)
```

```cpp
#include <hip/hip_runtime.h>
#include <hip/hip_cooperative_groups.h>
#include <cstdio>
#include <cstdint>

#define LAS __attribute__((address_space(3)))
typedef unsigned short bf16_t;
typedef short bf16x8 __attribute__((ext_vector_type(8)));
typedef float f32x4 __attribute__((ext_vector_type(4)));
typedef float f32x2 __attribute__((ext_vector_type(2)));
typedef unsigned u32x4 __attribute__((ext_vector_type(4)));
typedef unsigned u32x2 __attribute__((ext_vector_type(2)));

constexpr int MTOK = 16384, MCTX = 512, MALL = MTOK + MCTX, DM = 1024, NPROJ = 3072, PROJ_LD = 2560, DS = 512, FF = 2816;
constexpr int NCHP = 1280;
constexpr int UG_LD = 512;
constexpr float RMS_EPS = 1e-6f;

constexpr size_t MiB = 1u << 20;
constexpr size_t WS_CTL = 0, CTL_BYTES = 120 * 1024;
constexpr size_t WS_MOD = 1 * MiB;
constexpr size_t WS_WIN = 2 * MiB, WS_WGLU = 8 * MiB, WS_WA = 9 * MiB, WS_WPB = 10 * MiB, WS_WOUT = 11 * MiB, WS_WFFI = 13 * MiB, WS_WFFO = 24 * MiB;
constexpr size_t WS_W1 = 30 * MiB, WS_W2 = 34 * MiB;
constexpr size_t WS_H = 42 * MiB;
constexpr size_t WS_PROJ = 76 * MiB;
constexpr size_t WS_UG = 164 * MiB;
constexpr size_t WS_DP = 204 * MiB;
constexpr size_t WS_Y = 220 * MiB;
constexpr size_t WS_END = 236 * MiB;
constexpr int CW_BAR = 4096, CW_QUEUE = 8192, CW_BAR2 = 12288;
#ifndef DUP_MASK
#define DUP_MASK 0u
#endif

constexpr int RING_BYTES = 131072, LDSCTL_OFF = RING_BYTES, MISC_OFF = LDSCTL_OFF + 320, LDS_BYTES = 147456;

typedef __bf16 bf16x2_t __attribute__((ext_vector_type(2)));
__device__ __forceinline__ unsigned cvt_pk_bf16(float lo, float hi) { const f32x2 v = {lo, hi}; return __builtin_bit_cast(unsigned, __builtin_convertvector(v, bf16x2_t)); }
__device__ __forceinline__ f32x4 ld_nt(const float* p) { return __builtin_nontemporal_load((const f32x4*)p); }
__device__ __forceinline__ void st_nt(float* p, f32x4 v) { __builtin_nontemporal_store(v, (f32x4*)p); }
__device__ __forceinline__ int opaque_s(int v) { asm volatile("" : "+s"(v)); return v; }
__device__ __forceinline__ float bf_lo(unsigned w) { return __uint_as_float(w << 16); }
__device__ __forceinline__ float bf_hi(unsigned w) { return __uint_as_float(w & 0xffff0000u); }
__device__ __forceinline__ float sigmoidf_(float v) { return __builtin_amdgcn_rcpf(1.0f + __expf(-v)); }
__device__ __forceinline__ float gelu_tanh(float v) { const float u = 1.5957691216057308f * (v + 0.044715f * v * v * v); return v * sigmoidf_(u); }
template <int XM> __device__ __forceinline__ float swz_xor(float v) { return __builtin_bit_cast(float, __builtin_amdgcn_ds_swizzle(__builtin_bit_cast(int, v), (XM << 10) | 0x1f)); }
__device__ __forceinline__ float xor32(float v, int lane) { return __builtin_bit_cast(float, __builtin_amdgcn_ds_bpermute((lane ^ 32) << 2, __builtin_bit_cast(int, v))); }
__device__ __forceinline__ float wave_sum(float v) {
    v += swz_xor<1>(v); v += swz_xor<2>(v); v += swz_xor<4>(v); v += swz_xor<8>(v); v += swz_xor<16>(v);
    return __builtin_bit_cast(float, __builtin_amdgcn_readlane(__builtin_bit_cast(int, v), 0)) + __builtin_bit_cast(float, __builtin_amdgcn_readlane(__builtin_bit_cast(int, v), 32));
}

namespace pg8 {
constexpr int BM = 256, BK = 64, HALF = 128, HTB = HALF * BK * 2, NXCD = 8, WGM = 4;
__host__ __device__ __forceinline__ int lds_byte(int r, int c) { const int st = (r >> 4) * 2 + (c >> 5), rr = r & 15, cc = c & 31, ob = rr * 64 + cc * 2; return st * 1024 + (ob ^ (((ob >> 9) & 1) << 5)); }
__host__ __device__ __forceinline__ void stage_rc(int b, int& R, int& C) { const int st = b / 1024, sb = b % 1024, swz = sb ^ (((sb >> 9) & 1) << 5); R = (st >> 1) * 16 + swz / 64; C = (st & 1) * 32 + (swz % 64) / 2; }
__host__ __device__ __forceinline__ int perm32(int rho) { const int n = rho >> 4, i = rho & 15; return 8 * (i >> 2) + 4 * n + (i & 3); }

struct Unit { int pm, pn, g; };
struct Gemm { int K, lda, ldb; };

struct StaticOrder {
    const bf16_t* A; const bf16_t* Bt; int lda, ldb; int nM, nN, nwg, G, c;
    __device__ void init(const bf16_t* A_, const bf16_t* Bt_, int lda_, int ldb_, int M, int N, int G_, int c_) { A = A_; Bt = Bt_; lda = lda_; ldb = ldb_; nM = M / BM; nN = N / BM; nwg = nM * nN; G = G_; c = c_; }
    __device__ bool next(int i, Unit& u) const {
        const long L = (long)i * G + c; if (L >= nwg) return false;
        int wgid = (int)L; { const int q = nwg / NXCD, r = nwg % NXCD, xcd = wgid % NXCD, off = wgid / NXCD; wgid = (xcd < r ? xcd * (q + 1) : r * (q + 1) + (xcd - r) * q) + off; }
        const int nig = WGM * nN, gid = wgid / nig, fm = gid * WGM, gsz = (nM - fm) < WGM ? (nM - fm) : WGM;
        u.pm = fm + ((wgid % nig) % gsz); u.pn = (wgid % nig) / gsz; u.g = 0; return true;
    }
    __device__ __forceinline__ const char* a_base(const Unit& u) const { return (const char*)A + (size_t)u.pm * BM * lda * 2; }
    __device__ __forceinline__ const char* b_base(const Unit& u) const { return (const char*)Bt + (size_t)u.pn * BM * ldb * 2; }
};
struct ListOrder {
    const bf16_t* A; const bf16_t* Bt; int lda, ldb; int L0, stride, n, mode;
    __device__ bool next(int i, Unit& u) const { if (i >= n) return false; const int L = L0 + i * stride;
        if (mode == 0) { if (L < 128) { u.pm = 8 * (L >> 4) + (L & 7); u.pn = (L >> 3) & 1; } else { u.pm = L >> 1; u.pn = L & 1; } } else if (mode == 1) { u.pm = L / 10; u.pn = 2 + L % 10; }
        else if (mode == 3) { const int x = L0 & 7, k = L0 >> 3; u.pm = 6 * x + (k % 6); u.pn = 2 + 2 * i + (k / 6); }
        else if (mode == 4) { const int x = L0 & 7, k = L0 >> 3; u.pm = 48 + 2 * x + (k / 10); u.pn = 2 + (k % 10); }
        else { u.pm = L / 12; u.pn = L % 12; } u.g = 0; return true; }
    __device__ __forceinline__ const char* a_base(const Unit& u) const { return (const char*)A + (size_t)u.pm * BM * lda * 2; }
    __device__ __forceinline__ const char* b_base(const Unit& u) const { return (const char*)Bt + (size_t)u.pn * BM * ldb * 2; }
};
struct GroupOrder {
    const bf16_t* A; const bf16_t* Bt; int lda, ldb; int nM, nunits, G, c;
    __device__ void init(const bf16_t* A_, const bf16_t* Bt_, int lda_, int ldb_, int nM_, int G_, int c_) { A = A_; Bt = Bt_; lda = lda_; ldb = ldb_; nM = nM_; nunits = 32 * nM; G = G_; c = c_; }
    __device__ bool next(int i, Unit& u) const { const long L = (long)i * G + c; if (L >= nunits) return false;
        if (G == 160) { const int x = c & 7, k = c >> 3; u.g = x + 8 * (k / nM); u.pm = k % nM; }
        else { u.g = (int)L / nM; u.pm = (int)L % nM; } u.pn = 0; return true; }
    __device__ __forceinline__ const char* a_base(const Unit& u) const { return (const char*)A + ((size_t)u.g * NCHP + (size_t)u.pm * BM) * lda * 2; }
    __device__ __forceinline__ const char* b_base(const Unit& u) const { return (const char*)Bt + (size_t)u.g * BM * ldb * 2; }
};

template <class Epi, class Sched>
__device__ __forceinline__ void gemm_phase(LAS unsigned char* lds, const Gemm g, const Sched& S, const Epi& E) {
    int tid = threadIdx.x; asm volatile("" : "+v"(tid));
    const int wid = __builtin_amdgcn_readfirstlane(tid >> 6), lane = tid & 63, wr = wid >> 2, wc = wid & 3, fr = lane & 15, fq = lane >> 4;
    const int K = g.K, nt = K / BK;
    unsigned voffA[2], voffB[2];
#pragma unroll
    for (int i = 0; i < 2; ++i) { int R, C; stage_rc(tid * 16 + i * 8192, R, C); const int Rb = Epi::PERM ? ((R & ~31) + perm32(R & 31)) : R;
        voffA[i] = (unsigned)(R * g.lda + C) * 2u; voffB[i] = (unsigned)(Rb * g.ldb + C) * 2u; }
    const size_t kstep = (size_t)(BK * 2);
    const size_t hstepA = (size_t)HALF * g.lda * 2, hstepB = (size_t)HALF * g.ldb * 2;
    const unsigned ldsw = (unsigned)wid * 1024u;
    const int aoff = lds_byte(wr * 64 + fr, fq * 8), boff = lds_byte(wc * 32 + fr, fq * 8);
#define PG8_SA(b, h) (((b) * 2 + (h)) * HTB)
#define PG8_SB(b, h) ((4 + (b) * 2 + (h)) * HTB)
#define PG8_STAGE(bufoff, gbase, voff) do { _Pragma("unroll") for (int _i = 0; _i < 2; ++_i) \
        __builtin_amdgcn_global_load_lds((const unsigned*)((const char*)(gbase) + (voff)[_i]), (LAS unsigned*)(lds + (bufoff) + ldsw + _i * 8192), 16, 0, 0); } while (0)
#define PG8_LDA(dst, b, h) do { _Pragma("unroll") for (int m = 0; m < 4; ++m) _Pragma("unroll") for (int k = 0; k < 2; ++k) dst[m][k] = *(const LAS bf16x8*)(lds + PG8_SA(b, h) + aoff + m * 2048 + k * 1024); } while (0)
#define PG8_LDB(dst, b, h) do { _Pragma("unroll") for (int n = 0; n < 2; ++n) _Pragma("unroll") for (int k = 0; k < 2; ++k) dst[n][k] = *(const LAS bf16x8*)(lds + PG8_SB(b, h) + boff + n * 2048 + k * 1024); } while (0)
#define PG8_MMA(ai, bj, At, Bt) do { __builtin_amdgcn_s_setprio(1); _Pragma("unroll") for (int m = 0; m < 4; ++m) _Pragma("unroll") for (int n = 0; n < 2; ++n) _Pragma("unroll") for (int k = 0; k < 2; ++k) \
        acc[ai][bj][m][n] = __builtin_amdgcn_mfma_f32_16x16x32_bf16(Bt[n][k], At[m][k], acc[ai][bj][m][n], 0, 0, 0); __builtin_amdgcn_s_setprio(0); } while (0)
#define PG8_WAIT_V(n) asm volatile("s_waitcnt vmcnt(" #n ")" ::: "memory")
#define PG8_WAIT_L(n) asm volatile("s_waitcnt lgkmcnt(" #n ")" ::: "memory")
#define PG8_BAR __builtin_amdgcn_s_barrier()
#define PG8_SCHED __builtin_amdgcn_sched_barrier(0)
    Unit cur, nxt; int ui = 0;
    if (!S.next(0, cur)) return;
    f32x4 acc[2][2][4][2];
#pragma unroll
    for (int a = 0; a < 2; ++a)
#pragma unroll
        for (int b = 0; b < 2; ++b)
#pragma unroll
            for (int m = 0; m < 4; ++m)
#pragma unroll
                for (int n = 0; n < 2; ++n) acc[a][b][m][n] = (f32x4){0.f, 0.f, 0.f, 0.f};
    bf16x8 At[4][2], B0[2][2], B1[2][2];
    const char* cA = S.a_base(cur); const char* cB = S.b_base(cur);
    PG8_STAGE(PG8_SB(0, 0), cB, voffB); PG8_STAGE(PG8_SB(0, 1), cB + hstepB, voffB); PG8_STAGE(PG8_SA(0, 0), cA, voffA); PG8_STAGE(PG8_SA(0, 1), cA + hstepA, voffA);
    if (wr == 1) PG8_BAR;
    PG8_WAIT_V(2); PG8_BAR;
    PG8_STAGE(PG8_SB(1, 0), cB + kstep, voffB); PG8_STAGE(PG8_SA(1, 0), cA + kstep, voffA); PG8_STAGE(PG8_SB(1, 1), cB + hstepB + kstep, voffB);
    PG8_WAIT_V(6); PG8_BAR;
    for (;;) {
        const bool has_next = S.next(ui + 1, nxt);
        const char* nA = has_next ? S.a_base(nxt) : cA; const char* nB = has_next ? S.b_base(nxt) : cB;
        for (int t = 0; t < nt; t += 2) {
            const bool last = (t == nt - 2);
            const char* a1 = cA + (size_t)(t + 1) * kstep;
            const char* a2 = last ? nA : cA + (size_t)(t + 2) * kstep; const char* b2 = last ? nB : cB + (size_t)(t + 2) * kstep;
            const char* a3 = a2 + kstep; const char* b3 = b2 + kstep;
            if constexpr (Epi::MID) { if (t == (nt >> 1)) E.mid(acc, cur, wr, wc, fr, fq); }
            PG8_LDB(B0, 0, 0); PG8_LDB(B1, 0, 1); PG8_SCHED; PG8_LDA(At, 0, 0); PG8_STAGE(PG8_SA(1, 1), a1 + hstepA, voffA);
            PG8_WAIT_V(8); PG8_WAIT_L(0); PG8_BAR; PG8_MMA(0, 0, At, B0); PG8_MMA(0, 1, At, B1); PG8_BAR; PG8_SCHED;
            PG8_LDA(At, 0, 1); PG8_STAGE(PG8_SB(0, 0), b2, voffB); PG8_STAGE(PG8_SB(0, 1), b2 + hstepB, voffB); PG8_STAGE(PG8_SA(0, 0), a2, voffA);
            PG8_WAIT_V(8); PG8_WAIT_L(0); PG8_BAR; PG8_MMA(1, 0, At, B0); PG8_MMA(1, 1, At, B1); PG8_BAR; PG8_SCHED;
            PG8_LDB(B0, 1, 0); PG8_LDB(B1, 1, 1); PG8_SCHED; PG8_LDA(At, 1, 0); PG8_STAGE(PG8_SA(0, 1), a2 + hstepA, voffA);
            PG8_WAIT_V(8); PG8_WAIT_L(0); PG8_BAR; PG8_MMA(0, 0, At, B0); PG8_MMA(0, 1, At, B1); PG8_BAR; PG8_SCHED;
            PG8_LDA(At, 1, 1); PG8_STAGE(PG8_SB(1, 0), b3, voffB); PG8_STAGE(PG8_SB(1, 1), b3 + hstepB, voffB); PG8_STAGE(PG8_SA(1, 0), a3, voffA);
            PG8_WAIT_V(8); PG8_WAIT_L(0); PG8_BAR; PG8_MMA(1, 0, At, B0); PG8_MMA(1, 1, At, B1); PG8_BAR; PG8_SCHED;
        }
        if (wr == 0) PG8_BAR;
        E(acc, cur, wr, wc, fr, fq);
        if (!has_next) break;
#pragma unroll
        for (int a = 0; a < 2; ++a)
#pragma unroll
            for (int b = 0; b < 2; ++b)
#pragma unroll
                for (int m = 0; m < 4; ++m)
#pragma unroll
                    for (int n = 0; n < 2; ++n) acc[a][b][m][n] = (f32x4){0.f, 0.f, 0.f, 0.f};
        cur = nxt; cA = nA; cB = nB; ++ui;
        if (wr == 1) PG8_BAR;
    }
    PG8_WAIT_V(0);
    PG8_BAR;
#undef PG8_SA
#undef PG8_SB
#undef PG8_STAGE
#undef PG8_LDA
#undef PG8_LDB
#undef PG8_MMA
#undef PG8_WAIT_V
#undef PG8_WAIT_L
#undef PG8_BAR
#undef PG8_SCHED
}

#define EPI_LOOP_HEAD \
    _Pragma("unroll") for (int ai = 0; ai < 2; ++ai) _Pragma("unroll") for (int m = 0; m < 4; ++m) { const int row = u.pm * BM + ai * HALF + wr * 64 + m * 16 + fr; \
    _Pragma("unroll") for (int bj = 0; bj < 2; ++bj) {
#define EPI_LOOP_TAIL } }
__device__ __forceinline__ u32x4 pack8(const f32x4& v0, const f32x4& v1) { u32x4 w; w.x = cvt_pk_bf16(v0[0], v0[1]); w.y = cvt_pk_bf16(v0[2], v0[3]); w.z = cvt_pk_bf16(v1[0], v1[1]); w.w = cvt_pk_bf16(v1[2], v1[3]); return w; }
__device__ __forceinline__ void unpack8(const u32x4& w, f32x4& v0, f32x4& v1) { v0 = (f32x4){bf_lo(w.x), bf_hi(w.x), bf_lo(w.y), bf_hi(w.y)}; v1 = (f32x4){bf_lo(w.z), bf_hi(w.z), bf_lo(w.w), bf_hi(w.w)}; }

struct EpiProj { static constexpr bool PERM = true, MID = false; bf16_t* UG; bf16_t* PROJ;
    __device__ __forceinline__ void operator()(const f32x4 (&acc)[2][2][4][2], const Unit& u, int wr, int wc, int fr, int fq) const {
        if (u.pn >= 4) {
#pragma unroll
            for (int ai = 0; ai < 2; ++ai)
#pragma unroll
                for (int m = 0; m < 4; ++m) { const int row = u.pm * BM + ai * HALF + wr * 64 + m * 16 + fr, ch = (u.pn - 4) * HALF + wc * 32 + 8 * fq;
                    f32x4 r0, r1, s0, s1;
#pragma unroll
                    for (int e = 0; e < 4; ++e) { const float eb0 = __expf(-fmaxf(acc[ai][1][m][0][e], -60.f)), eb1 = __expf(-fmaxf(acc[ai][1][m][1][e], -60.f));
                        r0[e] = (1.0f + eb0) * __builtin_amdgcn_rcpf(1.0f + __expf(-acc[ai][0][m][0][e])); r1[e] = (1.0f + eb1) * __builtin_amdgcn_rcpf(1.0f + __expf(-acc[ai][0][m][1][e]));
                        s0[e] = __builtin_amdgcn_rcpf(1.0f + eb0); s1[e] = __builtin_amdgcn_rcpf(1.0f + eb1); }
                    bf16_t* p = PROJ + (size_t)row * PROJ_LD + 512 + ch;
                    *(u32x4*)p = pack8(r0, r1); *(u32x4*)(p + 1024) = pack8(s0, s1); }
            return;
        }
        EPI_LOOP_HEAD
            const int col = u.pn * BM + bj * HALF + wc * 32 + 8 * fq;
            bf16_t* dst = (u.pn < 2) ? UG + ((size_t)((col >> 4) * NCHP + (row >> 4)) * UG_LD + (row & 15) * 16 + (col & 15)) : PROJ + (size_t)row * PROJ_LD + (col - 512);
            *(u32x4*)dst = pack8(acc[ai][bj][m][0], acc[ai][bj][m][1]);
        EPI_LOOP_TAIL
    } };
struct EpiE { static constexpr bool PERM = false, MID = false; float* E;
    __device__ __forceinline__ void operator()(const f32x4 (&acc)[2][2][4][2], const Unit& u, int wr, int wc, int fr, int fq) const {
        EPI_LOOP_HEAD
            float* p = E + ((size_t)u.g * NCHP + row) * 256 + bj * HALF + wc * 32 + 4 * fq;
            *(f32x4*)p = acc[ai][bj][m][0]; *(f32x4*)(p + 16) = acc[ai][bj][m][1];
        EPI_LOOP_TAIL
    } };
struct EpiY { static constexpr bool PERM = true, MID = false; bf16_t* Y;
    __device__ __forceinline__ void operator()(const f32x4 (&acc)[2][2][4][2], const Unit& u, int wr, int wc, int fr, int fq) const {
        EPI_LOOP_HEAD
            if (row < MTOK / 16) {
                const int n0 = bj * HALF + wc * 32 + 8 * fq, j = n0 >> 4, c0 = n0 & 15;
                f32x4 v0 = acc[ai][bj][m][0], v1 = acc[ai][bj][m][1];
#pragma unroll
                for (int e = 0; e < 4; ++e) { v0[e] = gelu_tanh(v0[e]); v1[e] = gelu_tanh(v1[e]); }
                *(u32x4*)(Y + (size_t)(row * 16 + j) * DS + u.g * 16 + c0) = pack8(v0, v1);
            }
        EPI_LOOP_TAIL
    } };
struct EpiGlu { static constexpr bool PERM = true, MID = false; const bf16_t* Y; bf16_t* Z; const float* bias;
    __device__ __forceinline__ void operator()(const f32x4 (&acc)[2][2][4][2], const Unit& u, int wr, int wc, int fr, int fq) const {
        const int col0 = u.pn * BM + wc * 32 + 8 * fq;
        f32x4 bv[2][2];
#pragma unroll
        for (int bj = 0; bj < 2; ++bj) { bv[bj][0] = *(const f32x4*)(bias + col0 + bj * HALF); bv[bj][1] = *(const f32x4*)(bias + col0 + bj * HALF + 4); }
#pragma unroll
        for (int ai = 0; ai < 2; ++ai) {
            u32x4 yw[4][2];
#pragma unroll
            for (int m = 0; m < 4; ++m)
#pragma unroll
                for (int bj = 0; bj < 2; ++bj) yw[m][bj] = *(const u32x4*)(Y + (size_t)(u.pm * BM + ai * HALF + wr * 64 + m * 16 + fr) * DS + col0 + bj * HALF);
#pragma unroll
            for (int m = 0; m < 4; ++m)
#pragma unroll
                for (int bj = 0; bj < 2; ++bj) { const int row = u.pm * BM + ai * HALF + wr * 64 + m * 16 + fr;
                    f32x4 y0, y1; unpack8(yw[m][bj], y0, y1);
                    f32x4 v0 = acc[ai][bj][m][0] + bv[bj][0], v1 = acc[ai][bj][m][1] + bv[bj][1];
#pragma unroll
                    for (int e = 0; e < 4; ++e) { v0[e] = y0[e] * sigmoidf_(v0[e]); v1[e] = y1[e] * sigmoidf_(v1[e]); }
                    *(u32x4*)(Z + (size_t)row * DM + col0 + bj * HALF) = pack8(v0, v1); }
        }
    } };
struct EpiMerged { static constexpr bool PERM = true, MID = true; const bf16_t* gates; bf16_t* O;
    __device__ __forceinline__ void mid(f32x4 (&acc)[2][2][4][2], const Unit& u, int wr, int wc, int fr, int fq) const {
        const int col0 = u.pn * BM + wc * 32 + 8 * fq;
#pragma unroll
        for (int ai = 0; ai < 2; ++ai) {
            u32x4 gw[4][2];
#pragma unroll
            for (int m = 0; m < 4; ++m)
#pragma unroll
                for (int bj = 0; bj < 2; ++bj) gw[m][bj] = *(const u32x4*)(gates + (size_t)(u.pm * BM + ai * HALF + wr * 64 + m * 16 + fr) * PROJ_LD + col0 + bj * HALF);
#pragma unroll
            for (int m = 0; m < 4; ++m)
#pragma unroll
                for (int bj = 0; bj < 2; ++bj) { f32x4 a0, a1; unpack8(gw[m][bj], a0, a1); acc[ai][bj][m][0] *= a0; acc[ai][bj][m][1] *= a1; }
        }
    }
    __device__ __forceinline__ void operator()(const f32x4 (&acc)[2][2][4][2], const Unit& u, int wr, int wc, int fr, int fq) const {
        const int col0 = u.pn * BM + wc * 32 + 8 * fq;
#pragma unroll
        for (int ai = 0; ai < 2; ++ai) {
            u32x4 gw[4][2];
#pragma unroll
            for (int m = 0; m < 4; ++m)
#pragma unroll
                for (int bj = 0; bj < 2; ++bj) gw[m][bj] = *(const u32x4*)(gates + (size_t)(u.pm * BM + ai * HALF + wr * 64 + m * 16 + fr) * PROJ_LD + col0 + bj * HALF + 1024);
#pragma unroll
            for (int m = 0; m < 4; ++m)
#pragma unroll
                for (int bj = 0; bj < 2; ++bj) { const int row = u.pm * BM + ai * HALF + wr * 64 + m * 16 + fr; f32x4 g0, g1; unpack8(gw[m][bj], g0, g1);
                    *(u32x4*)(O + (size_t)row * DM + col0 + bj * HALF) = pack8(acc[ai][bj][m][0] * g0, acc[ai][bj][m][1] * g1); }
        }
    } };
struct EpiResid { static constexpr bool PERM = false, MID = false; const float* base; float* out; const float* gvec;
    __device__ __forceinline__ void operator()(const f32x4 (&acc)[2][2][4][2], const Unit& u, int wr, int wc, int fr, int fq) const {
        EPI_LOOP_HEAD
            const int col = u.pn * BM + bj * HALF + wc * 32 + 4 * fq;
            const float* gv = gvec + (row >> 13) * 6144 + col;
            const size_t o = (size_t)row * DM + col;
            *(f32x4*)(out + o) = *(const f32x4*)(base + o) + *(const f32x4*)gv * acc[ai][bj][m][0];
            *(f32x4*)(out + o + 16) = *(const f32x4*)(base + o + 16) + *(const f32x4*)(gv + 16) * acc[ai][bj][m][1];
        EPI_LOOP_TAIL
    } };
struct EpiResidB { static constexpr bool PERM = true, MID = false; const bf16_t* base; float* out; const float* gvec;
    __device__ __forceinline__ void operator()(const f32x4 (&acc)[2][2][4][2], const Unit& u, int wr, int wc, int fr, int fq) const {
        EPI_LOOP_HEAD
            const int col = u.pn * BM + bj * HALF + wc * 32 + 8 * fq; const float* gv = gvec + (row >> 13) * 6144 + col; float* op = out + (size_t)row * DM + col;
            f32x4 b0, b1; unpack8(*(const u32x4*)(base + (size_t)row * DM + col), b0, b1);
            *(f32x4*)op = b0 + *(const f32x4*)gv * acc[ai][bj][m][0]; *(f32x4*)(op + 4) = b1 + *(const f32x4*)(gv + 4) * acc[ai][bj][m][1];
        EPI_LOOP_TAIL
    } };
struct EpiSwiglu { static constexpr bool PERM = true, MID = false; bf16_t* O;
    __device__ __forceinline__ void operator()(const f32x4 (&acc)[2][2][4][2], const Unit& u, int wr, int wc, int fr, int fq) const {
#pragma unroll
        for (int ai = 0; ai < 2; ++ai)
#pragma unroll
            for (int m = 0; m < 4; ++m) { const int row = u.pm * BM + ai * HALF + wr * 64 + m * 16 + fr;
                f32x4 v0 = acc[ai][0][m][0], v1 = acc[ai][0][m][1];
#pragma unroll
                for (int e = 0; e < 4; ++e) { v0[e] = v0[e] * sigmoidf_(v0[e]) * acc[ai][1][m][0][e]; v1[e] = v1[e] * sigmoidf_(v1[e]) * acc[ai][1][m][1][e]; }
                *(u32x4*)(O + (size_t)row * FF + u.pn * HALF + wc * 32 + 8 * fq) = pack8(v0, v1); }
    } };
struct EpiResidNorm { static constexpr bool PERM = true, MID = false; const float* x; float* X1; const float* mod; const float* gam; bf16_t* H2; float* rowss;
    __device__ __forceinline__ void operator()(const f32x4 (&acc)[2][2][4][2], const Unit& u, int wr, int wc, int fr, int fq) const {
        const int col0 = u.pn * BM + wc * 32 + 8 * fq; const float* mb = mod + ((u.pm * BM) >> 13) * 6144;
        f32x4 g1v[2][2], hv[2][2];
#pragma unroll
        for (int bj = 0; bj < 2; ++bj)
#pragma unroll
            for (int n = 0; n < 2; ++n) { const int c = col0 + bj * HALF + 4 * n; g1v[bj][n] = *(const f32x4*)(mb + 2048 + c); hv[bj][n] = *(const f32x4*)(gam + c) * (*(const f32x4*)(mb + 4096 + c) + 1.0f); }
#pragma unroll
        for (int ai = 0; ai < 2; ++ai)
#pragma unroll
            for (int mh = 0; mh < 2; ++mh) {
                f32x4 xv[2][2][2];
#pragma unroll
                for (int mm = 0; mm < 2; ++mm)
#pragma unroll
                    for (int bj = 0; bj < 2; ++bj) { const float* xp = x + (size_t)(u.pm * BM + ai * HALF + wr * 64 + (mh * 2 + mm) * 16 + fr) * DM + col0 + bj * HALF; xv[mm][bj][0] = ld_nt(xp); xv[mm][bj][1] = ld_nt(xp + 4); }
#pragma unroll
                for (int mm = 0; mm < 2; ++mm) { const int m = mh * 2 + mm, row = u.pm * BM + ai * HALF + wr * 64 + m * 16 + fr; float ss = 0.f;
#pragma unroll
                    for (int bj = 0; bj < 2; ++bj) { const size_t o = (size_t)row * DM + col0 + bj * HALF;
                        const f32x4 x0 = xv[mm][bj][0] + g1v[bj][0] * acc[ai][bj][m][0], x1 = xv[mm][bj][1] + g1v[bj][1] * acc[ai][bj][m][1];
                        ss += ((x0.x * x0.x + x0.y * x0.y) + (x0.z * x0.z + x0.w * x0.w)) + ((x1.x * x1.x + x1.y * x1.y) + (x1.z * x1.z + x1.w * x1.w));
                        *(f32x4*)(X1 + o) = x0; *(f32x4*)(X1 + o + 4) = x1;
                        *(u32x4*)(H2 + o) = pack8(x0 * hv[bj][0], x1 * hv[bj][1]); }
                    ss += swz_xor<16>(ss); ss += xor32(ss, fq * 16 + fr);
                    if (fq == 0) atomicAdd(rowss + row, ss); }
            }
    } };
struct EpiSwigluN { static constexpr bool PERM = true, MID = false; bf16_t* O; const float* rowss; const float* bias2;
    __device__ __forceinline__ void operator()(const f32x4 (&acc)[2][2][4][2], const Unit& u, int wr, int wc, int fr, int fq) const {
        const float* bb = bias2 + ((u.pm * BM) >> 13) * (2 * FF) + u.pn * BM + wc * 32 + 8 * fq;
        const f32x4 bg0 = *(const f32x4*)bb, bg1 = *(const f32x4*)(bb + 4), bu0 = *(const f32x4*)(bb + HALF), bu1 = *(const f32x4*)(bb + HALF + 4);
        float rs[8];
#pragma unroll
        for (int k = 0; k < 8; ++k) rs[k] = rowss[u.pm * BM + (k >> 2) * HALF + wr * 64 + (k & 3) * 16 + fr];
#pragma unroll
        for (int k = 0; k < 8; ++k) rs[k] = __builtin_amdgcn_rsqf(rs[k] * (1.0f / DM) + RMS_EPS);
#pragma unroll
        for (int ai = 0; ai < 2; ++ai)
#pragma unroll
            for (int m = 0; m < 4; ++m) { const int row = u.pm * BM + ai * HALF + wr * 64 + m * 16 + fr; const float rstd = rs[ai * 4 + m];
                f32x4 g0 = acc[ai][0][m][0] * rstd + bg0, g1 = acc[ai][0][m][1] * rstd + bg1;
                const f32x4 u0 = acc[ai][1][m][0] * rstd + bu0, u1 = acc[ai][1][m][1] * rstd + bu1;
#pragma unroll
                for (int e = 0; e < 4; ++e) { g0[e] = g0[e] * sigmoidf_(g0[e]) * u0[e]; g1[e] = g1[e] * sigmoidf_(g1[e]) * u1[e]; }
                *(u32x4*)(O + (size_t)row * FF + u.pn * HALF + wc * 32 + 8 * fq) = pack8(g0, g1); }
    } };
struct EpiResidFinal { static constexpr bool PERM = true, MID = false; float* out; const float* gvec; const float* fg; float* rowss; unsigned* pcnt;
    __device__ __forceinline__ void operator()(f32x4 (&acc)[2][2][4][2], const Unit& u, int wr, int wc, int fr, int fq) const {
        const int col0 = u.pn * BM + wc * 32 + 8 * fq; const float* gv = gvec + ((u.pm * BM) >> 13) * 6144;
        f32x4 g2v[2][2];
#pragma unroll
        for (int bj = 0; bj < 2; ++bj)
#pragma unroll
            for (int n = 0; n < 2; ++n) g2v[bj][n] = *(const f32x4*)(gv + col0 + bj * HALF + 4 * n);
#pragma unroll
        for (int ai = 0; ai < 2; ++ai)
#pragma unroll
            for (int mh = 0; mh < 2; ++mh) {
                f32x4 xv[2][2][2];
#pragma unroll
                for (int mm = 0; mm < 2; ++mm)
#pragma unroll
                    for (int bj = 0; bj < 2; ++bj) { const float* bp = out + (size_t)(u.pm * BM + ai * HALF + wr * 64 + (mh * 2 + mm) * 16 + fr) * DM + col0 + bj * HALF; xv[mm][bj][0] = *(const f32x4*)bp; xv[mm][bj][1] = *(const f32x4*)(bp + 4); }
#pragma unroll
                for (int mm = 0; mm < 2; ++mm) { const int m = mh * 2 + mm, row = u.pm * BM + ai * HALF + wr * 64 + m * 16 + fr; float ss = 0.f;
#pragma unroll
                    for (int bj = 0; bj < 2; ++bj) {
                        const f32x4 x0 = xv[mm][bj][0] + g2v[bj][0] * acc[ai][bj][m][0], x1 = xv[mm][bj][1] + g2v[bj][1] * acc[ai][bj][m][1];
                        acc[ai][bj][m][0] = x0; acc[ai][bj][m][1] = x1;
                        ss += ((x0.x * x0.x + x0.y * x0.y) + (x0.z * x0.z + x0.w * x0.w)) + ((x1.x * x1.x + x1.y * x1.y) + (x1.z * x1.z + x1.w * x1.w)); }
                    ss += swz_xor<16>(ss); ss += xor32(ss, fq * 16 + fr);
                    if (fq == 0) atomicAdd(rowss + row, ss); }
            }
        f32x4 fgv[2][2];
#pragma unroll
        for (int bj = 0; bj < 2; ++bj)
#pragma unroll
            for (int n = 0; n < 2; ++n) fgv[bj][n] = *(const f32x4*)(fg + col0 + bj * HALF + 4 * n);
        asm volatile("s_waitcnt vmcnt(0)" ::: "memory");
        __builtin_amdgcn_s_barrier();
        if (threadIdx.x == 0) {
            unsigned* pc = pcnt + 64 * u.pm;
            __hip_atomic_fetch_add(pc, 1u, __ATOMIC_RELAXED, __HIP_MEMORY_SCOPE_AGENT);
            unsigned sp = 0;
            while (__hip_atomic_load(pc, __ATOMIC_RELAXED, __HIP_MEMORY_SCOPE_AGENT) < 4u) { __builtin_amdgcn_s_sleep(1); if (++sp > (1u << 22)) break; }
        }
        __builtin_amdgcn_s_barrier();
        asm volatile("" ::: "memory");
        float rs[8];
#pragma unroll
        for (int k = 0; k < 8; ++k) rs[k] = __hip_atomic_load(rowss + u.pm * BM + (k >> 2) * HALF + wr * 64 + (k & 3) * 16 + fr, __ATOMIC_RELAXED, __HIP_MEMORY_SCOPE_AGENT);
#pragma unroll
        for (int k = 0; k < 8; ++k) rs[k] = __builtin_amdgcn_rsqf(rs[k] * (1.0f / DM) + RMS_EPS);
#pragma unroll
        for (int ai = 0; ai < 2; ++ai)
#pragma unroll
            for (int m = 0; m < 4; ++m) { const int row = u.pm * BM + ai * HALF + wr * 64 + m * 16 + fr; const float rstd = rs[ai * 4 + m];
#pragma unroll
                for (int bj = 0; bj < 2; ++bj) { float* op = out + (size_t)row * DM + col0 + bj * HALF;
                    st_nt(op, acc[ai][bj][m][0] * rstd * fgv[bj][0]); st_nt(op + 4, acc[ai][bj][m][1] * rstd * fgv[bj][1]); } }
    } };
}

#define XB_TMO      128
#define XB_XCNT(j)  (256  + 64 * (j))
#define XB_XSUB(j)  (1280 + 64 * (j))
#define XB_XGEN(j)  (2304 + 64 * (j))
#define XB_TOP      3328
#define XB_TOPGEN   3392
#define XCD_BAR_WORDS 3456
#define XB_SPIN_CAP (1u << 22)
__device__ __forceinline__ unsigned xb_ld(unsigned* p)              { return __hip_atomic_load(p, __ATOMIC_RELAXED, __HIP_MEMORY_SCOPE_AGENT); }
__device__ __forceinline__ unsigned xb_add(unsigned* p, unsigned v) { return __hip_atomic_fetch_add(p, v, __ATOMIC_RELAXED, __HIP_MEMORY_SCOPE_AGENT); }
__device__ __forceinline__ unsigned xb_xcc_id() { return (unsigned)__builtin_amdgcn_s_getreg((3 << 11) | 20) & 0xFu; }
#define XB_SPIN(cond, bar) do { unsigned _sp = 0; while (cond) { __builtin_amdgcn_s_sleep(1); \
    if ((++_sp & 255u) == 0u) { if (xb_ld(&(bar)[XB_TMO])) break; if (_sp > XB_SPIN_CAP) { atomicAdd(&(bar)[XB_TMO], 1u); break; } } } } while (0)
struct XcdBarrier { unsigned* bar; unsigned x; volatile LAS unsigned* st; unsigned gsize; };
__device__ __forceinline__ XcdBarrier xcd_barrier_post(unsigned* bar, volatile LAS unsigned* st, unsigned gsize) {
    XcdBarrier b; b.bar = bar; b.x = xb_xcc_id(); b.st = st; b.gsize = gsize;
    if (threadIdx.x == 0) (void)xb_add(&bar[XB_XCNT(b.x)], 1u);
    return b;
}
__device__ __forceinline__ void xcd_barrier_complete(unsigned* bar, unsigned x, unsigned& nloc, unsigned& nx, const unsigned G) {
    unsigned sum, cnt, mine, sp = 0u;
    for (;;) {
        sum = 0u; cnt = 0u; mine = 0u;
#pragma unroll
        for (unsigned j = 0; j < 16; ++j) { const unsigned c = xb_ld(&bar[XB_XCNT(j)]); sum += c; cnt += (c > 0u) ? 1u : 0u; mine = (j == x) ? c : mine; }
        if (sum == G) break;
        __builtin_amdgcn_s_sleep(1);
        if ((++sp & 255u) == 0u) { if (xb_ld(&bar[XB_TMO])) break; if (sp > XB_SPIN_CAP) { atomicAdd(&bar[XB_TMO], 1u); break; } }
    }
    nloc = mine > 0u ? mine : 1u; nx = cnt > 0u ? cnt : 1u;
}
__device__ __forceinline__ void xcd_barrier(const XcdBarrier& b) {
    asm volatile("s_waitcnt vmcnt(0)" ::: "memory");
    __syncthreads();
    if (threadIdx.x == 0) {
        unsigned* bar = b.bar;
        __builtin_amdgcn_s_waitcnt(0);
        unsigned nloc = b.st[0], nx = b.st[1];
        if (nloc == 0u) { xcd_barrier_complete(bar, b.x, nloc, nx, b.gsize); b.st[0] = nloc; b.st[1] = nx; }
        const unsigned old = xb_add(&bar[XB_XSUB(b.x)], 1u);
        const unsigned gen = old / nloc;
        if (old + 1u == (gen + 1u) * nloc) {
            __builtin_amdgcn_fence(__ATOMIC_RELEASE, "agent");
            asm volatile("s_waitcnt vmcnt(0)" ::: "memory");
            const unsigned og = xb_add(&bar[XB_TOP], 1u);
            const unsigned tg = og / nx;
            if (og + 1u == (tg + 1u) * nx) xb_add(&bar[XB_TOPGEN], 1u);
            else XB_SPIN(xb_ld(&bar[XB_TOPGEN]) == tg, bar);
            __builtin_amdgcn_fence(__ATOMIC_ACQUIRE, "agent");
            xb_add(&bar[XB_XGEN(b.x)], 1u);
            asm volatile("s_waitcnt vmcnt(0)" ::: "memory");
        } else {
            XB_SPIN(xb_ld(&bar[XB_XGEN(b.x)]) == gen, bar);
            __builtin_amdgcn_fence(__ATOMIC_ACQUIRE, "agent");
            asm volatile("s_waitcnt vmcnt(0)" ::: "memory");
        }
    }
    __syncthreads();
}

struct Args { const float* in[27]; float* out; unsigned char* ws; };
#define KAS __attribute__((address_space(4)))
__device__ __forceinline__ const KAS char* karg_ptr() { const KAS char* kp = (const KAS char*)__builtin_amdgcn_kernarg_segment_ptr(); asm volatile("" : "+s"(kp)); return kp; }
__device__ __forceinline__ const float* AIN(int k) { return *(const float* const KAS*)(karg_ptr() + 8 * k); }
__device__ __forceinline__ float* AOUT() { return *(float* const KAS*)(karg_ptr() + 8 * 27); }
__device__ __forceinline__ unsigned char* AWS() { return *(unsigned char* const KAS*)(karg_ptr() + 8 * 28); }

__device__ __forceinline__ void transpose_item(const float* W, int N, bf16_t* WT, int ldt, int dest_row0, int k0, int n0, LAS float* scr, int lane) {
#pragma unroll 8
    for (int i = 0; i < 32; ++i) { const int kk = 2 * i + (lane >> 5); scr[kk * 33 + (lane & 31)] = W[(size_t)(k0 + kk) * N + n0 + (lane & 31)]; }
    asm volatile("s_waitcnt lgkmcnt(0)" ::: "memory");
    const int c = lane & 7;
#pragma unroll
    for (int j = 0; j < 4; ++j) { const int n = (lane >> 3) + 8 * j; const LAS float* s = scr + (8 * c) * 33 + n;
        u32x4 o; o.x = cvt_pk_bf16(s[0 * 33], s[1 * 33]); o.y = cvt_pk_bf16(s[2 * 33], s[3 * 33]); o.z = cvt_pk_bf16(s[4 * 33], s[5 * 33]); o.w = cvt_pk_bf16(s[6 * 33], s[7 * 33]);
        *(u32x4*)(WT + (size_t)(dest_row0 + n) * ldt + k0 + 8 * c) = o; }
    asm volatile("s_waitcnt lgkmcnt(0)" ::: "memory");
}

__device__ __forceinline__ void norm_mod_row(const float* xrow, const float* gam, const float* sh, const float* sc, bf16_t* orow, int lane) {
    f32x4 v[4]; float s = 0.f;
#pragma unroll
    for (int j = 0; j < 4; ++j) { v[j] = ((const f32x4*)xrow)[lane + 64 * j]; s += (v[j].x * v[j].x + v[j].y * v[j].y) + (v[j].z * v[j].z + v[j].w * v[j].w); }
    const float rstd = __builtin_amdgcn_rsqf(wave_sum(s) * (1.0f / DM) + RMS_EPS);
#pragma unroll
    for (int j = 0; j < 4; ++j) { const int ci = lane + 64 * j; const f32x4 g = ((const f32x4*)gam)[ci], a = ((const f32x4*)sc)[ci], b = ((const f32x4*)sh)[ci];
        const f32x4 h = (v[j] * rstd * g) * (a + 1.0f) + b;
        u32x2 o; o.x = cvt_pk_bf16(h.x, h.y); o.y = cvt_pk_bf16(h.z, h.w); ((u32x2*)orow)[ci] = o; }
}

template <int W> __device__ __forceinline__ void pool_column(LAS bf16_t* col) {
    float u[64], cs[65];
    cs[0] = 0.f;
#pragma unroll
    for (int q = 0; q < 64; ++q) { u[q] = __uint_as_float((unsigned)col[q * 512] << 16); cs[q + 1] = cs[q] + u[q]; }
#pragma unroll
    for (int q = 0; q < 64; ++q) {
        constexpr int dummy = 0; (void)dummy;
        const int lo = (q - W / 2) < 0 ? 0 : (q - W / 2); int hi = q + W - 1 - W / 2; hi = (hi > 63 ? 63 : hi) + 1;
        const float mean = (cs[hi] - cs[lo]) * (1.0f / (float)(hi - lo));
        col[q * 512] = (bf16_t)(cvt_pk_bf16(mean - u[q], 0.f) & 0xffffu);
    }
}

#define modx ((float*)(ws + 65536))
#define modc ((float*)(ws + 65536 + 49152))
#define ATg ((float*)(ws + WS_MOD + 131072))
#define Win_t ((bf16_t*)(ws + WS_WIN))
#define Wglu_t ((bf16_t*)(ws + WS_WGLU))
#define Wcat_t ((bf16_t*)(ws + WS_WA))
#define Wout_t ((bf16_t*)(ws + WS_WOUT))
#define Wffi_t ((bf16_t*)(ws + WS_WFFI))
#define Wffo_t ((bf16_t*)(ws + WS_WFFO))
#define W1_t ((bf16_t*)(ws + WS_W1))
#define W2_t ((bf16_t*)(ws + WS_W2))
#define H ((bf16_t*)(ws + WS_H))
#define PROJ ((bf16_t*)(ws + WS_PROJ))
#define AFFN ((bf16_t*)(ws + WS_PROJ))
#define UG ((bf16_t*)(ws + WS_UG))
#define ZD ((bf16_t*)(ws + WS_UG))
#define Y ((bf16_t*)(ws + WS_Y))
#define H2 ((bf16_t*)(ws + WS_DP))
#define X1B ((bf16_t*)(ws + WS_UG))
#define BIAS2 ((float*)(ws + WS_MOD + 196608))
#define ROWSS ((float*)(ws + 131072))
#define ROWSS2 ((float*)(ws + 196608))
#define PCNT ((unsigned*)(ws + 262144))

constexpr int I_IN = 16 * 12, I_GLU = 8 * 2, I_A = 8 * 4, I_OUT = 16 * 4, I_FFI = 16 * 22, I_FFO = 44 * 4;
constexpr int I_EARLY = I_IN + I_GLU + I_A + I_OUT, I_LATE = I_FFI + I_FFO;
__device__ __forceinline__ void copy_item(int r, LAS unsigned char* lds, unsigned char* ws, int tid) {
    const float* W; int N, ldt, kb, nb, perm = 0; bf16_t* WT;
    if (r < I_IN) { W = AIN(8); N = 3072; WT = Win_t; ldt = 1024; kb = r / 12; nb = r % 12; perm = 2; }
    else if ((r -= I_IN) < I_GLU) { W = AIN(17); N = 512; WT = Wglu_t; ldt = 512; kb = r / 2; nb = r % 2; }
    else if ((r -= I_GLU) < I_A) { W = AIN(21); N = 1024; WT = Wcat_t; ldt = 1024; kb = r / 4; nb = r % 4; }
    else if ((r -= I_A) < I_OUT) { W = AIN(23); N = 1024; WT = Wout_t; ldt = 1024; kb = r / 4; nb = r % 4; }
    else if ((r -= I_OUT) < I_FFI) { W = AIN(24); N = 2 * FF; WT = Wffi_t; ldt = 1024; kb = r / 22; nb = r % 22; perm = 1; }
    else { r -= I_FFI; W = AIN(25); N = 1024; WT = Wffo_t; ldt = FF; kb = r / 4; nb = r % 4; }
    const int k0 = kb * 64, n0 = nb * 256;
    LAS unsigned* tile = (LAS unsigned*)lds;
    f32x4 v[8];
#pragma unroll
    for (int rr = 0; rr < 8; ++rr) { const int flat = rr * 512 + tid, k = flat >> 6, c4 = flat & 63; v[rr] = ld_nt(W + (size_t)(k0 + k) * N + n0 + c4 * 4); }
#pragma unroll
    for (int rr = 0; rr < 8; ++rr) { const int flat = rr * 512 + tid, k = flat >> 6, c4 = flat & 63;
        tile[k * 129 + c4 * 2] = cvt_pk_bf16(v[rr].x, v[rr].y); tile[k * 129 + c4 * 2 + 1] = cvt_pk_bf16(v[rr].z, v[rr].w); }
    __syncthreads();
#pragma unroll
    for (int i = 0; i < 2; ++i) { const int task = tid + 512 * i, kc = task & 7, np = task >> 3; unsigned w[8];
#pragma unroll
        for (int e = 0; e < 8; ++e) w[e] = tile[(8 * kc + e) * 129 + np];
        u32x4 lo, hi;
        lo.x = __builtin_amdgcn_perm(w[1], w[0], 0x05040100u); lo.y = __builtin_amdgcn_perm(w[3], w[2], 0x05040100u); lo.z = __builtin_amdgcn_perm(w[5], w[4], 0x05040100u); lo.w = __builtin_amdgcn_perm(w[7], w[6], 0x05040100u);
        hi.x = __builtin_amdgcn_perm(w[1], w[0], 0x07060302u); hi.y = __builtin_amdgcn_perm(w[3], w[2], 0x07060302u); hi.z = __builtin_amdgcn_perm(w[5], w[4], 0x07060302u); hi.w = __builtin_amdgcn_perm(w[7], w[6], 0x07060302u);
        const int n = n0 + 2 * np; int drow = n;
        if (perm == 1) { const int nn = n < FF ? n : n - FF; drow = 256 * (nn >> 7) + (n < FF ? 0 : 128) + (nn & 127); }
        else if (perm == 2 && n >= 1024) { const int isb = (n - 1024) >> 10, ch = (n - 1024) & 1023; drow = 1024 + 256 * (ch >> 7) + isb * 128 + (ch & 127); }
        bf16_t* dst = WT + (size_t)drow * ldt + k0 + 8 * kc;
        *(u32x4*)dst = lo; *(u32x4*)(dst + ldt) = hi; }
    __syncthreads();
}
__device__ __forceinline__ void late_copies(int cap, LAS unsigned char* lds, unsigned char* ws) {
    unsigned* qctr = (unsigned*)(ws + WS_CTL) + CW_QUEUE + 2048;
    volatile LAS unsigned* qw = (volatile LAS unsigned*)(lds + MISC_OFF) + 16;
    for (int i = 0; i < cap; ++i) {
        int tid = threadIdx.x; asm volatile("" : "+v"(tid));
        if (tid == 0) *qw = atomicAdd(qctr, 1u);
        __syncthreads();
        const int it = (int)*qw;
        __syncthreads();
        if (it >= I_LATE) break;
        copy_item(I_EARLY + it, lds, ws, tid);
    }
}

__global__ void __launch_bounds__(512, 2) mega_fwd(Args args) {
    extern __shared__ __attribute__((aligned(16))) unsigned char lds_raw[];
    LAS unsigned char* lds = (LAS unsigned char*)lds_raw;
#define PHASE_IDS() int tid = threadIdx.x; asm volatile("" : "+v"(tid)); const int lane = tid & 63, wave = __builtin_amdgcn_readfirstlane(tid >> 6); (void)lane; (void)wave
    const int G = gridDim.x, bid = blockIdx.x;
    for (int u = threadIdx.x; u < (LDS_BYTES - LDSCTL_OFF) / 4; u += 512) ((LAS unsigned*)(lds + LDSCTL_OFF))[u] = 0u;
    __syncthreads();
    { unsigned* z = (unsigned*)(AWS() + 131072); for (int i = bid * 512 + threadIdx.x; i < (278528 - 131072) / 4; i += G * 512) z[i] = 0u; }
    XcdBarrier bar = xcd_barrier_post((unsigned*)(AWS() + WS_CTL) + CW_BAR, (volatile LAS unsigned*)(lds + MISC_OFF) + 8, (unsigned)G);
    constexpr int NS = 160; const bool teams = (G == 256);
    XcdBarrier tbar = bar;
    if (teams && bid < NS) tbar = xcd_barrier_post((unsigned*)(AWS() + WS_CTL) + CW_BAR2, (volatile LAS unsigned*)(lds + MISC_OFF) + 10, (unsigned)NS);
#define GRID_BAR() xcd_barrier(bar)

    _Pragma("unroll") for (int rep_ = 0; rep_ < (int)((DUP_MASK >> 0) & 1u) + 1; ++rep_) {
    {
        LAS float* fl = (LAS float*)lds;
        unsigned char* ws = AWS();
        unsigned* qctr = (unsigned*)(ws + WS_CTL) + CW_QUEUE + 64 * rep_;
        volatile LAS unsigned* qw = (volatile LAS unsigned*)(lds + MISC_OFF) + 16;
        constexpr int Q_S5 = 128, Q_WPB = 64, Q_GEMV = 256;
        const bool defer = teams;
        const int I_COPY = defer ? I_EARLY : I_EARLY + I_LATE; constexpr int Q_NORM = MALL / 64;
        const int NITEMS = Q_S5 + Q_WPB + Q_GEMV + I_COPY + Q_NORM;
        unsigned* gemv_done = (unsigned*)(ws + WS_CTL) + CW_QUEUE + 1024;
        bool mod_ready = false;
        unsigned pre = (threadIdx.x == 0) ? atomicAdd(qctr, 1u) : 0u;
        for (;;) {
            PHASE_IDS();
            if (tid == 0) *qw = pre;
            __syncthreads();
            int it = (int)*qw;
            if (tid == 0 && it < NITEMS) pre = atomicAdd(qctr, 1u);
            __syncthreads();
            if (it >= NITEMS) break;
            it = it < Q_GEMV ? it + Q_S5 + Q_WPB : (it < Q_GEMV + Q_S5 + Q_WPB ? it - Q_GEMV : it);
            if (it < Q_S5) {
                const int g = it >> 2, part = it & 3;
                const float* a_re = AIN(9); const float* a_im = AIN(10); const float* log_dt = AIN(11);
                const float* b_re = AIN(12); const float* b_im = AIN(13); const float* c_re = AIN(14); const float* c_im = AIN(15); const float* s5_d = AIN(16);
                LAS float* AP = fl;
                LAS float* BB = fl + 4480;
                LAS float* CC = fl + 8576;
                LAS float* KD = fl + 12800;
                LAS float* CF = fl + 20992;
                {
                    const int d1 = (tid >> 6) & 1, p1 = tid & 63, eg = tid >> 7, gi1 = (d1 * 32 + g) * 64 + p1;
                    const float are = a_re[gi1], aim = a_im[gi1], ldt = log_dt[d1 * 32 + g];
                    float bre[4], bim[4];
#pragma unroll
                    for (int i = 0; i < 4; ++i) { const int idx = tid + 512 * i, d = idx >> 10, p = (idx >> 4) & 63, c = idx & 15; const size_t gx = (size_t)((d * 32 + g) * 64 + p) * 16 + c; bre[i] = b_re[gx]; bim[i] = b_im[gx]; }
#pragma unroll
                    for (int i = 0; i < 4; ++i) { const int idx = tid + 512 * i, d = idx >> 10, c = (idx >> 6) & 15, p = idx & 63; const int cidx = ((d * 32 + g) * 16 + c) * 64 + p;
                        CC[(d * 16 + c) * 130 + p * 2] = c_re[cidx]; CC[(d * 16 + c) * 130 + p * 2 + 1] = c_im[cidx]; }
                    const float dt = expf(ldt), xr = dt * are, yi = dt * aim;
#pragma unroll
                    for (int i = 0; i < 5; ++i) { const int e = eg + 4 * i;
                        if (e <= 16) { const float mag = expf((float)e * xr); float sn, cs; sincosf((float)e * yi, &sn, &cs);
                            AP[(d1 * 17 + e) * 130 + p1 * 2] = mag * cs; AP[(d1 * 17 + e) * 130 + p1 * 2 + 1] = mag * sn;
                            if (e == 16 && part == 0) { ATg[((g * 2 + d1) * 64 + p1) * 2] = mag * cs; ATg[((g * 2 + d1) * 64 + p1) * 2 + 1] = mag * sn; } } }
                    if (eg == 0) {
                        float sn, cs; sincosf(yi, &sn, &cs); const float sh = sinf(0.5f * yi);
                        const float nr = expm1f(xr) * cs - 2.0f * sh * sh, ni = expf(xr) * sn;
                        const float den = are * are + aim * aim;
                        CF[(d1 * 64 + p1) * 2] = (nr * are + ni * aim) / den; CF[(d1 * 64 + p1) * 2 + 1] = (ni * are - nr * aim) / den;
                    }
                    __syncthreads();
#pragma unroll
                    for (int i = 0; i < 4; ++i) { const int idx = tid + 512 * i, d = idx >> 10, p = (idx >> 4) & 63, c = idx & 15; const float cr = CF[(d * 64 + p) * 2], ci = CF[(d * 64 + p) * 2 + 1];
                        BB[((d * 64 + p) * 16 + c) * 2] = cr * bre[i] - ci * bim[i]; BB[((d * 64 + p) * 16 + c) * 2 + 1] = cr * bim[i] + ci * bre[i]; }
                }
                __syncthreads();
                {
                    const int ci = lane & 15, kq = lane >> 4;
                    for (int t = 0; t < 4; ++t) { const int mt = wave * 4 + t, d = mt >> 4, dl = mt & 15;
                        f32x4 kacc = {0.f, 0.f, 0.f, 0.f};
#pragma unroll 8
                        for (int ks = 0; ks < 32; ++ks) { const int p = 2 * ks + (kq >> 1);
                            const f32x2 cv = *(const LAS f32x2*)(CC + (d * 16 + ci) * 130 + p * 2), av = *(const LAS f32x2*)(AP + (d * 17 + dl) * 130 + p * 2);
                            const float av_ = (kq & 1) ? -(cv.x * av.y + cv.y * av.x) : (cv.x * av.x - cv.y * av.y);
                            const float bv_ = BB[((d * 64 + p) * 16 + ci) * 2 + (kq & 1)];
                            kacc = __builtin_amdgcn_mfma_f32_16x16x4f32(av_, bv_, kacc, 0, 0, 0); }
#pragma unroll
                        for (int rg = 0; rg < 4; ++rg) KD[((d * 16 + dl) * 16 + kq * 4 + rg) * 16 + ci] = kacc[rg]; }
                }
                __syncthreads();
                for (int q = tid; q < 64 * 64; q += 512) {
                    const int n = part * 64 + (q >> 6), k0 = (q & 63) * 8, j = n >> 4, c = n & 15; float v[8];
                    if (k0 < 256) { const int i = k0 >> 4, c20 = k0 & 15;
#pragma unroll
                        for (int e = 0; e < 8; ++e) { const int c2 = c20 + e;
                            v[e] = (i < j) ? KD[((0 * 16 + (j - i)) * 16 + c) * 16 + c2] : (i > j) ? KD[((1 * 16 + (i - j)) * 16 + c) * 16 + c2]
                                 : KD[((0 * 16 + 0) * 16 + c) * 16 + c2] + KD[((1 * 16 + 0) * 16 + c) * 16 + c2] + (c == c2 ? s5_d[g * 16 + c] : 0.f); }
                    } else { const int k2 = k0 - 256, d = k2 >> 7, ri = (k2 >> 6) & 1, p0 = k2 & 63, ex = d == 0 ? j + 1 : 16 - j;
#pragma unroll
                        for (int e = 0; e < 8; ++e) { const int p = p0 + e; const float cr = CC[(d * 16 + c) * 130 + p * 2], ci = CC[(d * 16 + c) * 130 + p * 2 + 1];
                            const float ar = AP[(d * 17 + ex) * 130 + p * 2], ai = AP[(d * 17 + ex) * 130 + p * 2 + 1];
                            v[e] = ri == 0 ? (cr * ar - ci * ai) : -(cr * ai + ci * ar); } }
                    u32x4 o; o.x = cvt_pk_bf16(v[0], v[1]); o.y = cvt_pk_bf16(v[2], v[3]); o.z = cvt_pk_bf16(v[4], v[5]); o.w = cvt_pk_bf16(v[6], v[7]);
                    *(u32x4*)(W2_t + ((size_t)g * 256 + n) * 512 + k0) = o;
                }
                for (int q = tid; q < 64 * 32; q += 512) {
                    const int n = part * 64 + (q >> 5), k0 = (q & 31) * 8, d = n >> 7, ri = (n >> 6) & 1, p = n & 63, i = k0 >> 4, c0 = k0 & 15, ex = d == 0 ? 15 - i : i;
                    const float ar = AP[(d * 17 + ex) * 130 + p * 2], ai = AP[(d * 17 + ex) * 130 + p * 2 + 1]; float v[8];
#pragma unroll
                    for (int e = 0; e < 8; ++e) { const float br = BB[((d * 64 + p) * 16 + c0 + e) * 2], bi = BB[((d * 64 + p) * 16 + c0 + e) * 2 + 1];
                        v[e] = ri == 0 ? (ar * br - ai * bi) : (ar * bi + ai * br); }
                    u32x4 o; o.x = cvt_pk_bf16(v[0], v[1]); o.y = cvt_pk_bf16(v[2], v[3]); o.z = cvt_pk_bf16(v[4], v[5]); o.w = cvt_pk_bf16(v[6], v[7]);
                    *(u32x4*)(W1_t + ((size_t)g * 256 + n) * 256 + k0) = o;
                }
                __syncthreads();
                continue;
            }
            it -= Q_S5;
            if (it < Q_WPB) {
                const float* pool_w = AIN(19); const float* pool_scale = AIN(20); const float* wb = AIN(22);
                const int j = it >> 4, n0 = (it & 15) * 64;
                LAS float* pw = fl; LAS float* wbs = fl + 128 * 128;
#pragma unroll
                for (int i = 0; i < 8; ++i) { const int idx = tid + 512 * i; *(LAS f32x4*)(pw + idx * 4) = *(const f32x4*)(pool_w + (size_t)j * 16384 + idx * 4); }
#pragma unroll
                for (int i = 0; i < 4; ++i) { const int idx = tid + 512 * i, q = idx >> 4, n4 = idx & 15;
                    *(LAS f32x4*)(wbs + q * 64 + n4 * 4) = *(const f32x4*)(wb + (size_t)(j * 128 + q) * 1024 + n0 + n4 * 4) * pool_scale[j * 128 + q]; }
                __syncthreads();
                const int n = tid & 63, kg = tid >> 6;
                float accp[16];
#pragma unroll
                for (int i = 0; i < 16; ++i) accp[i] = 0.f;
                for (int q4 = 0; q4 < 32; ++q4) { float wv[4];
#pragma unroll
                    for (int t = 0; t < 4; ++t) wv[t] = wbs[(4 * q4 + t) * 64 + n];
#pragma unroll
                    for (int i = 0; i < 16; ++i) { const f32x4 pv = *(const LAS f32x4*)(pw + (kg * 16 + i) * 128 + 4 * q4); accp[i] += (pv.x * wv[0] + pv.y * wv[1]) + (pv.z * wv[2] + pv.w * wv[3]); } }
                u32x4 o0, o1;
                o0.x = cvt_pk_bf16(accp[0], accp[1]); o0.y = cvt_pk_bf16(accp[2], accp[3]); o0.z = cvt_pk_bf16(accp[4], accp[5]); o0.w = cvt_pk_bf16(accp[6], accp[7]);
                o1.x = cvt_pk_bf16(accp[8], accp[9]); o1.y = cvt_pk_bf16(accp[10], accp[11]); o1.z = cvt_pk_bf16(accp[12], accp[13]); o1.w = cvt_pk_bf16(accp[14], accp[15]);
                bf16_t* dst = Wcat_t + (size_t)(n0 + n) * 1024 + 512 + j * 128 + kg * 16;
                *(u32x4*)dst = o0; *(u32x4*)(dst + 8) = o1;
                __syncthreads();
                continue;
            }
            it -= Q_WPB;
            if (it < Q_GEMV) {
                if (rep_ == 0) {
                const float* cvec = AIN(1); const float* cctx = AIN(3); const float* w_mod = AIN(4); const float* b_mod = AIN(5);
                const int col0 = (it & 63) * 96, kq = it >> 6, kbase = kq * 256;
                for (int i = tid; i < 768; i += 512) { const int which = i >> 8, kk = i & 255;
                    const float v = which == 0 ? cvec[kbase + kk] : which == 1 ? cvec[1024 + kbase + kk] : cctx[kbase + kk]; fl[i] = v * sigmoidf_(v); }
                __syncthreads();
                if (tid < 384) { const int kg = tid / 24, cq = tid % 24;
                    f32x4 a0 = {0.f, 0.f, 0.f, 0.f}, a1 = a0, a2 = a0;
#pragma unroll
                    for (int i = 0; i < 16; ++i) { const int kk = kg + 16 * i; const f32x4 w = ld_nt(w_mod + (size_t)(kbase + kk) * 6144 + col0 + cq * 4);
                        a0 += w * fl[kk]; a1 += w * fl[256 + kk]; a2 += w * fl[512 + kk]; }
                    LAS float* r = fl + 768 + (kg * 24 + cq) * 12;
                    *(LAS f32x4*)r = a0; *(LAS f32x4*)(r + 4) = a1; *(LAS f32x4*)(r + 8) = a2; }
                __syncthreads();
                if (tid < 288) { const int which = tid / 96, c = tid % 96, col = col0 + c; float sacc = 0.f;
#pragma unroll
                    for (int q = 0; q < 16; ++q) sacc += fl[768 + (q * 24 + (c >> 2)) * 12 + which * 4 + (c & 3)];
                    if (kq == 0) sacc += b_mod[col];
                    if (which < 2) atomicAdd(modx + which * 6144 + col, sacc); else if (col < 2048) atomicAdd(modc + col, sacc); }
                asm volatile("s_waitcnt vmcnt(0)" ::: "memory");
                __syncthreads();
                if (tid == 0) __hip_atomic_fetch_add(gemv_done, 1u, __ATOMIC_RELAXED, __HIP_MEMORY_SCOPE_AGENT);
                }
                continue;
            }
            it -= Q_GEMV;
            if (it < I_COPY) { copy_item(it, lds, ws, tid); continue; }
            it -= I_COPY;
            {
                if (!mod_ready) {
                    if (tid == 0) { unsigned sp = 0; while (__hip_atomic_load(gemv_done, __ATOMIC_RELAXED, __HIP_MEMORY_SCOPE_AGENT) < (unsigned)Q_GEMV) { __builtin_amdgcn_s_sleep(2); if (++sp > (1u << 22)) break; }
                        __builtin_amdgcn_fence(__ATOMIC_ACQUIRE, "agent"); asm volatile("s_waitcnt vmcnt(0)" ::: "memory"); }
                    __syncthreads(); mod_ready = true;
                }
                const float* x = AIN(0); const float* ctx = AIN(2); const float* norm1_g = AIN(6);
                for (int hb = 0; hb < 2; ++hb) {
                const int m0 = it * 64 + wave * 8 + hb * 4; const bool lat = m0 < MTOK;
                const float* src = lat ? x + (size_t)m0 * DM : ctx + (size_t)(m0 - MTOK) * DM;
                const float* shp = lat ? modx + (m0 >> 13) * 6144 : modc; const float* scp = shp + 1024;
                f32x4 v[4][4]; float ss[4];
#pragma unroll
                for (int r = 0; r < 4; ++r) { ss[r] = 0.f;
#pragma unroll
                    for (int j = 0; j < 4; ++j) v[r][j] = ld_nt(src + (size_t)r * DM + 4 * (lane + 64 * j)); }
#pragma unroll
                for (int r = 0; r < 4; ++r) {
#pragma unroll
                    for (int j = 0; j < 4; ++j) ss[r] += (v[r][j].x * v[r][j].x + v[r][j].y * v[r][j].y) + (v[r][j].z * v[r][j].z + v[r][j].w * v[r][j].w);
                    const float rstd = __builtin_amdgcn_rsqf(wave_sum(ss[r]) * (1.0f / DM) + RMS_EPS);
                    bf16_t* orow = H + (size_t)(m0 + r) * DM;
#pragma unroll
                    for (int j = 0; j < 4; ++j) { const int ci = lane + 64 * j; const f32x4 g = ((const f32x4*)norm1_g)[ci], a = ((const f32x4*)scp)[ci], b = ((const f32x4*)shp)[ci];
                        const f32x4 h = (v[r][j] * rstd * g) * (a + 1.0f) + b;
                        u32x2 o; o.x = cvt_pk_bf16(h.x, h.y); o.y = cvt_pk_bf16(h.z, h.w); ((u32x2*)orow)[ci] = o; } }
                }
            }
        }
    }
    GRID_BAR();
    }

    {
      const bool inS = !teams || bid < NS; const int CG = teams ? NS : G;
      {
        {
          unsigned char* ws = AWS(); pg8::ListOrder S; S.A = H; S.Bt = Win_t; S.lda = DM; S.ldb = DM; S.stride = 1; S.n = 0; S.L0 = 0; S.mode = 1;
          if (!teams) { S.L0 = bid; S.stride = G; S.n = bid < 792 ? (792 - bid + G - 1) / G : 0; S.mode = 2; }
          else if (bid < NS) { S.L0 = bid; S.n = bid < 132 ? 1 : 0; S.mode = 0; }
          else { S.L0 = bid - NS; S.n = 5; S.mode = 3; }
          pg8::EpiProj E{UG, PROJ};
          pg8::gemm_phase(lds, pg8::Gemm{DM, DM, DM}, S, E);
        }
        if (inS) {
          if (teams && bid >= 132) late_copies(5, lds, AWS());
          xcd_barrier(tbar);
          { unsigned char* ws = AWS(); pg8::GroupOrder S; S.init(UG, W1_t, UG_LD, 256, NCHP / 256, CG, bid); pg8::EpiE E{AOUT()};
            pg8::gemm_phase(lds, pg8::Gemm{256, UG_LD, 256}, S, E); }
          xcd_barrier(tbar);
    { PHASE_IDS(); unsigned char* ws = AWS(); const float* Ebuf = AOUT();
      LAS float* sx = (LAS float*)lds;
      for (int task = bid; task < 128; task += CG) {
        const int b = task >> 6, dir = (task >> 5) & 1, g = task & 31, p = lane;
        const float aTr = ATg[((g * 2 + dir) * 64 + p) * 2], aTi = ATg[((g * 2 + dir) * 64 + p) * 2 + 1];
        const float* Eg = Ebuf + (size_t)g * NCHP * 256 + dir * 128 + p;
        float er[64], ei[64];
        const int r0 = b * 512 + (dir ? 511 - wave * 64 : wave * 64); const long estep = dir ? -256 : 256, ustep = dir ? -UG_LD : UG_LD;
        { const float* ep = Eg + (size_t)r0 * 256;
#pragma unroll
          for (int i = 0; i < 64; ++i) { er[i] = ep[0]; ei[i] = ep[64]; ep += estep; } }
        if (wave == 0) {
            float cr[16], ci[16]; float sr = 0.f, si = 0.f;
#pragma unroll
            for (int i = 0; i < 16; ++i) { const int r = 1024 + b * 16 + (dir ? 15 - i : i); cr[i] = Eg[(size_t)r * 256]; ci[i] = Eg[(size_t)r * 256 + 64]; }
#pragma unroll
            for (int i = 0; i < 16; ++i) { const float nr = aTr * sr - aTi * si + cr[i], ni = aTr * si + aTi * sr + ci[i]; sr = nr; si = ni; }
            sx[(8 * 2 + 0) * 64 + p] = sr; sx[(8 * 2 + 1) * 64 + p] = si;
        }
        { float sr = 0.f, si = 0.f;
#pragma unroll
          for (int i = 0; i < 64; ++i) { const float nr = aTr * sr - aTi * si + er[i], ni = aTr * si + aTi * sr + ei[i]; sr = nr; si = ni; }
          sx[(wave * 2 + 0) * 64 + p] = sr; sx[(wave * 2 + 1) * 64 + p] = si; }
        __syncthreads();
        float sr = sx[(8 * 2 + 0) * 64 + p], si = sx[(8 * 2 + 1) * 64 + p];
        { float qr = aTr, qi = aTi;
#pragma unroll
          for (int k = 0; k < 6; ++k) { const float nr = qr * qr - qi * qi, ni = 2.0f * qr * qi; qr = nr; qi = ni; }
          for (int k = 0; k < wave; ++k) { const float tr = sx[(k * 2 + 0) * 64 + p], ti = sx[(k * 2 + 1) * 64 + p];
              const float nr = qr * sr - qi * si + tr, ni = qr * si + qi * sr + ti; sr = nr; si = ni; } }
        bf16_t* up = UG + (size_t)g * NCHP * UG_LD + 256 + dir * 128 + p + (size_t)r0 * UG_LD;
#pragma unroll
        for (int i = 0; i < 64; ++i) {
            const unsigned pk = cvt_pk_bf16(sr, si);
            up[0] = (bf16_t)(pk & 0xffffu); up[64] = (bf16_t)(pk >> 16); up += ustep;
            const float nr = aTr * sr - aTi * si + er[i], ni = aTr * si + aTi * sr + ei[i]; sr = nr; si = ni; }
        __syncthreads();
      } }
          if (teams && bid >= 128) late_copies(2, lds, AWS());
          xcd_barrier(tbar);
          if (teams && bid >= 128) late_copies(6, lds, AWS());
          { unsigned char* ws = AWS(); pg8::GroupOrder S; S.init(UG, W2_t, UG_LD, 512, MTOK / 16 / 256, CG, bid); pg8::EpiY E{Y};
            pg8::gemm_phase(lds, pg8::Gemm{512, UG_LD, 512}, S, E); }
        }
        if (teams && bid < NS) {
          unsigned char* ws = AWS(); pg8::ListOrder S; S.A = H; S.Bt = Win_t; S.lda = DM; S.ldb = DM; S.stride = 1; S.n = 1; S.L0 = bid; S.mode = 4;
          pg8::EpiProj E{UG, PROJ};
          pg8::gemm_phase(lds, pg8::Gemm{DM, DM, DM}, S, E);
        }
      }
    }
    GRID_BAR();

    _Pragma("unroll") for (int rep_ = 0; rep_ < (int)((DUP_MASK >> 6) & 1u) + 1; ++rep_) {
    { unsigned char* ws = AWS(); pg8::StaticOrder S; S.init(Y, Wglu_t, DS, DS, MTOK, DS, G, bid); pg8::EpiGlu E{Y, ZD, AIN(18)};
      pg8::gemm_phase(lds, pg8::Gemm{DS, DS, DS}, S, E); }
    { const int nidle = G - 128; const bool split = nidle >= 64;
      for (int s = split ? bid - 128 : bid; s >= 0 && s < 256; s += split ? nidle : G) {
        PHASE_IDS(); unsigned char* ws = AWS();
        LAS bf16_t* slab = (LAS bf16_t*)lds;
        const size_t tok0 = (size_t)s * 64;
        __syncthreads();
#pragma unroll
        for (int i = 0; i < 8; ++i) { const int q = tid + 512 * i, row = q >> 6, cc = q & 63;
            *(LAS u32x4*)(slab + row * 512 + cc * 8) = *(const u32x4*)(PROJ + (tok0 + row) * PROJ_LD + cc * 8); }
        __syncthreads();
        { const int j = wave >> 1; LAS bf16_t* col = slab + tid;
          if (j == 0) pool_column<2>(col); else if (j == 1) pool_column<4>(col); else if (j == 2) pool_column<8>(col); else pool_column<16>(col); }
        __syncthreads();
#pragma unroll
        for (int i = 0; i < 8; ++i) { const int q = tid + 512 * i, row = q >> 6, cc = q & 63;
            *(u32x4*)(ZD + (tok0 + row) * DM + 512 + cc * 8) = *(const LAS u32x4*)(slab + row * 512 + cc * 8); }
      } }
    if (teams && bid >= 128) late_copies(2, lds, AWS());
    { PHASE_IDS(); unsigned char* ws = AWS();
      const bool split = G >= 192; const int gw = (split ? bid - 128 : bid) * 8 + wave, NGW = (split ? G - 128 : G) * 8;
      for (int r = gw; r >= 0 && r < 2 * FF; r += NGW) {
        const u32x4* wrow = (const u32x4*)(Wffi_t + (size_t)r * DM) + lane * 2; f32x4 w0, w1, w2, w3; pg8::unpack8(wrow[0], w0, w1); pg8::unpack8(wrow[1], w2, w3);
        float sb[2];
#pragma unroll
        for (int b = 0; b < 2; ++b) { const f32x4* sp = (const f32x4*)(modx + b * 6144 + 3072) + lane * 4; const f32x4 a0 = sp[0] * w0, a1 = sp[1] * w1, a2 = sp[2] * w2, a3 = sp[3] * w3;
            sb[b] = wave_sum(((a0.x + a0.y) + (a0.z + a0.w)) + ((a1.x + a1.y) + (a1.z + a1.w)) + ((a2.x + a2.y) + (a2.z + a2.w)) + ((a3.x + a3.y) + (a3.z + a3.w))); }
        if (lane == 0) { BIAS2[r] = sb[0]; BIAS2[2 * FF + r] = sb[1]; }
      } }
    GRID_BAR();
    }

    _Pragma("unroll") for (int rep_ = 0; rep_ < (int)((DUP_MASK >> 7) & 1u) + 1; ++rep_) {
    { unsigned char* ws = AWS(); pg8::StaticOrder S; S.init(ZD, Wcat_t, DM, DM, MTOK, DM, G, bid); pg8::EpiMerged E{PROJ + 512, H};
      pg8::gemm_phase(lds, pg8::Gemm{DM, DM, DM}, S, E); }
    GRID_BAR();
    }

    { unsigned char* ws = AWS(); pg8::StaticOrder S; S.init(H, Wout_t, DM, DM, MTOK, DM, G, bid); pg8::EpiResidNorm E{AIN(0), AOUT(), modx, AIN(7), H2, ROWSS};
      pg8::gemm_phase(lds, pg8::Gemm{DM, DM, DM}, S, E); }
    GRID_BAR();

    _Pragma("unroll") for (int rep_ = 0; rep_ < (int)((DUP_MASK >> 10) & 1u) + 1; ++rep_) {
    { unsigned char* ws = AWS(); pg8::StaticOrder S; S.init(H2, Wffi_t, DM, DM, MTOK, 2 * FF, G, bid); pg8::EpiSwigluN E{AFFN, ROWSS, BIAS2};
      pg8::gemm_phase(lds, pg8::Gemm{DM, DM, DM}, S, E); }
    GRID_BAR();
    }

    if (G == 256) {
      unsigned char* ws = AWS(); float* out = AOUT(); pg8::StaticOrder S; S.init(AFFN, Wffo_t, FF, FF, MTOK, DM, G, bid); pg8::EpiResidFinal E{out, modx + 5120, AIN(26), ROWSS2, PCNT};
      pg8::gemm_phase(lds, pg8::Gemm{FF, FF, FF}, S, E);
    } else {
      { unsigned char* ws = AWS(); float* out = AOUT(); pg8::StaticOrder S; S.init(AFFN, Wffo_t, FF, FF, MTOK, DM, G, bid); pg8::EpiResid E{out, out, modx + 5120};
        pg8::gemm_phase(lds, pg8::Gemm{FF, FF, FF}, S, E); }
      GRID_BAR();
      { const float* fg = AIN(26); float* out = AOUT(); PHASE_IDS();
        for (int m = bid * 8 + wave; m < MTOK; m += G * 8) {
          float* row = out + (size_t)m * DM; f32x4 v[4]; float s = 0.f;
#pragma unroll
          for (int j = 0; j < 4; ++j) { v[j] = ((const f32x4*)row)[lane + 64 * j]; s += (v[j].x * v[j].x + v[j].y * v[j].y) + (v[j].z * v[j].z + v[j].w * v[j].w); }
          const float rstd = __builtin_amdgcn_rsqf(wave_sum(s) * (1.0f / DM) + RMS_EPS);
#pragma unroll
          for (int j = 0; j < 4; ++j) ((f32x4*)row)[lane + 64 * j] = v[j] * rstd * ((const f32x4*)fg)[lane + 64 * j];
        } }
    }
}

extern "C" void kernel_launch(void* const* d_in, const int* in_sizes, int n_in, void* d_out, int out_size, void* d_ws, size_t ws_size, hipStream_t stream) {
    static int grid = 0;
    if (grid == 0) {
        int dev = 0, cus = 0, per_cu = 0;
        if (n_in != 27 || ws_size < WS_END || out_size != MTOK * DM) { fprintf(stderr, "kernel_launch: unexpected sizes (n_in %d, ws %zu, out %d)\n", n_in, ws_size, out_size); grid = -1; return; }
        if (hipGetDevice(&dev) != hipSuccess || hipDeviceGetAttribute(&cus, hipDeviceAttributeMultiprocessorCount, dev) != hipSuccess) { grid = -1; return; }
        if (hipFuncSetAttribute((const void*)mega_fwd, hipFuncAttributeMaxDynamicSharedMemorySize, LDS_BYTES) != hipSuccess) { fprintf(stderr, "kernel_launch: hipFuncSetAttribute failed\n"); grid = -1; return; }
        if (hipOccupancyMaxActiveBlocksPerMultiprocessor(&per_cu, (const void*)mega_fwd, 512, LDS_BYTES) != hipSuccess || per_cu < 1) { fprintf(stderr, "kernel_launch: occupancy query failed (%d)\n", per_cu); (void)hipGetLastError(); per_cu = 1; }
        grid = cus * per_cu;
    }
    if (grid < 0) return;
    (void)hipMemsetAsync((char*)d_ws + WS_CTL + 16384, 0, CTL_BYTES - 16384, stream);
    Args a{};
    for (int i = 0; i < 27; ++i) a.in[i] = (const float*)d_in[i];
    a.out = (float*)d_out; a.ws = (unsigned char*)d_ws;
    void* kargs[] = {&a};
    hipError_t e = hipLaunchCooperativeKernel((const void*)mega_fwd, dim3(grid), dim3(512), kargs, LDS_BYTES, stream);
    if (e != hipSuccess) fprintf(stderr, "kernel_launch: cooperative launch failed: %s (grid %d)\n", hipGetErrorString(e), grid);
}
```

```cpp
#include <hip/hip_runtime.h>
#include <hip/hip_cooperative_groups.h>
#include <cstdio>
#include <cstdint>

#define LAS __attribute__((address_space(3)))
typedef unsigned short bf16_t;
typedef short bf16x8 __attribute__((ext_vector_type(8)));
typedef float f32x4 __attribute__((ext_vector_type(4)));
typedef float f32x2 __attribute__((ext_vector_type(2)));
typedef unsigned u32x4 __attribute__((ext_vector_type(4)));
typedef unsigned u32x2 __attribute__((ext_vector_type(2)));

constexpr int MTOK = 16384, MCTX = 512, MALL = MTOK + MCTX, DM = 1024, NPROJ = 3072, PROJ_LD = 2560, DS = 512, FF = 2816;
constexpr int NCHP = 1280;
constexpr int UG_LD = 512;
constexpr float RMS_EPS = 1e-6f;

constexpr size_t MiB = 1u << 20;
constexpr size_t WS_CTL = 0, CTL_BYTES = 120 * 1024;
constexpr size_t WS_MOD = 1 * MiB;
constexpr size_t WS_WIN = 2 * MiB, WS_WGLU = 8 * MiB, WS_WA = 9 * MiB, WS_WPB = 10 * MiB, WS_WOUT = 11 * MiB, WS_WFFI = 13 * MiB, WS_WFFO = 24 * MiB;
constexpr size_t WS_W1 = 30 * MiB, WS_W2 = 34 * MiB;
constexpr size_t WS_H = 42 * MiB;
constexpr size_t WS_PROJ = 76 * MiB;
constexpr size_t WS_UG = 164 * MiB;
constexpr size_t WS_DP = 204 * MiB;
constexpr size_t WS_Y = 220 * MiB;
constexpr size_t WS_END = 236 * MiB;
constexpr int CW_BAR = 4096, CW_QUEUE = 8192, CW_BAR2 = 12288;
#ifndef DUP_MASK
#define DUP_MASK 0u
#endif

constexpr int RING_BYTES = 131072, LDSCTL_OFF = RING_BYTES, MISC_OFF = LDSCTL_OFF + 320, LDS_BYTES = 147456;

typedef __bf16 bf16x2_t __attribute__((ext_vector_type(2)));
__device__ __forceinline__ unsigned cvt_pk_bf16(float lo, float hi) { const f32x2 v = {lo, hi}; return __builtin_bit_cast(unsigned, __builtin_convertvector(v, bf16x2_t)); }
__device__ __forceinline__ f32x4 ld_nt(const float* p) { return __builtin_nontemporal_load((const f32x4*)p); }
__device__ __forceinline__ void st_nt(float* p, f32x4 v) { __builtin_nontemporal_store(v, (f32x4*)p); }
__device__ __forceinline__ int opaque_s(int v) { asm volatile("" : "+s"(v)); return v; }
__device__ __forceinline__ float bf_lo(unsigned w) { return __uint_as_float(w << 16); }
__device__ __forceinline__ float bf_hi(unsigned w) { return __uint_as_float(w & 0xffff0000u); }
__device__ __forceinline__ float sigmoidf_(float v) { return __builtin_amdgcn_rcpf(1.0f + __expf(-v)); }
__device__ __forceinline__ float gelu_tanh(float v) { const float u = 1.5957691216057308f * (v + 0.044715f * v * v * v); return v * sigmoidf_(u); }
template <int XM> __device__ __forceinline__ float swz_xor(float v) { return __builtin_bit_cast(float, __builtin_amdgcn_ds_swizzle(__builtin_bit_cast(int, v), (XM << 10) | 0x1f)); }
__device__ __forceinline__ float xor32(float v, int lane) { return __builtin_bit_cast(float, __builtin_amdgcn_ds_bpermute((lane ^ 32) << 2, __builtin_bit_cast(int, v))); }
__device__ __forceinline__ float wave_sum(float v) {
    v += swz_xor<1>(v); v += swz_xor<2>(v); v += swz_xor<4>(v); v += swz_xor<8>(v); v += swz_xor<16>(v);
    return __builtin_bit_cast(float, __builtin_amdgcn_readlane(__builtin_bit_cast(int, v), 0)) + __builtin_bit_cast(float, __builtin_amdgcn_readlane(__builtin_bit_cast(int, v), 32));
}

namespace pg8 {
constexpr int BM = 256, BK = 64, HALF = 128, HTB = HALF * BK * 2, NXCD = 8, WGM = 4;
__host__ __device__ __forceinline__ int lds_byte(int r, int c) { const int st = (r >> 4) * 2 + (c >> 5), rr = r & 15, cc = c & 31, ob = rr * 64 + cc * 2; return st * 1024 + (ob ^ (((ob >> 9) & 1) << 5)); }
__host__ __device__ __forceinline__ void stage_rc(int b, int& R, int& C) { const int st = b / 1024, sb = b % 1024, swz = sb ^ (((sb >> 9) & 1) << 5); R = (st >> 1) * 16 + swz / 64; C = (st & 1) * 32 + (swz % 64) / 2; }
__host__ __device__ __forceinline__ int perm32(int rho) { const int n = rho >> 4, i = rho & 15; return 8 * (i >> 2) + 4 * n + (i & 3); }

struct Unit { int pm, pn, g; };
struct Gemm { int K, lda, ldb; };

struct StaticOrder {
    const bf16_t* A; const bf16_t* Bt; int lda, ldb; int nM, nN, nwg, G, c;
    __device__ void init(const bf16_t* A_, const bf16_t* Bt_, int lda_, int ldb_, int M, int N, int G_, int c_) { A = A_; Bt = Bt_; lda = lda_; ldb = ldb_; nM = M / BM; nN = N / BM; nwg = nM * nN; G = G_; c = c_; }
    __device__ bool next(int i, Unit& u) const {
        const long L = (long)i * G + c; if (L >= nwg) return false;
        int wgid = (int)L; { const int q = nwg / NXCD, r = nwg % NXCD, xcd = wgid % NXCD, off = wgid / NXCD; wgid = (xcd < r ? xcd * (q + 1) : r * (q + 1) + (xcd - r) * q) + off; }
        const int nig = WGM * nN, gid = wgid / nig, fm = gid * WGM, gsz = (nM - fm) < WGM ? (nM - fm) : WGM;
        u.pm = fm + ((wgid % nig) % gsz); u.pn = (wgid % nig) / gsz; u.g = 0; return true;
    }
    __device__ __forceinline__ const char* a_base(const Unit& u) const { return (const char*)A + (size_t)u.pm * BM * lda * 2; }
    __device__ __forceinline__ const char* b_base(const Unit& u) const { return (const char*)Bt + (size_t)u.pn * BM * ldb * 2; }
};
struct ListOrder {
    const bf16_t* A; const bf16_t* Bt; int lda, ldb; int L0, stride, n, mode;
    __device__ bool next(int i, Unit& u) const { if (i >= n) return false; const int L = L0 + i * stride;
        if (mode == 0) { u.pm = L >> 1; u.pn = L & 1; } else if (mode == 1) { u.pm = L / 10; u.pn = 2 + L % 10; }
        else if (mode == 3) { const int x = L0 & 7, k = L0 >> 3; u.pm = 6 * x + (k % 6); u.pn = 2 + 2 * i + (k / 6); }
        else if (mode == 4) { const int x = L0 & 7, k = L0 >> 3; u.pm = 48 + 2 * x + (k / 10); u.pn = 2 + (k % 10); }
        else { u.pm = L / 12; u.pn = L % 12; } u.g = 0; return true; }
    __device__ __forceinline__ const char* a_base(const Unit& u) const { return (const char*)A + (size_t)u.pm * BM * lda * 2; }
    __device__ __forceinline__ const char* b_base(const Unit& u) const { return (const char*)Bt + (size_t)u.pn * BM * ldb * 2; }
};
struct GroupOrder {
    const bf16_t* A; const bf16_t* Bt; int lda, ldb; int nM, nunits, G, c;
    __device__ void init(const bf16_t* A_, const bf16_t* Bt_, int lda_, int ldb_, int nM_, int G_, int c_) { A = A_; Bt = Bt_; lda = lda_; ldb = ldb_; nM = nM_; nunits = 32 * nM; G = G_; c = c_; }
    __device__ bool next(int i, Unit& u) const { const long L = (long)i * G + c; if (L >= nunits) return false; u.g = (int)L / nM; u.pm = (int)L % nM; u.pn = 0; return true; }
    __device__ __forceinline__ const char* a_base(const Unit& u) const { return (const char*)A + ((size_t)u.g * NCHP + (size_t)u.pm * BM) * lda * 2; }
    __device__ __forceinline__ const char* b_base(const Unit& u) const { return (const char*)Bt + (size_t)u.g * BM * ldb * 2; }
};

template <class Epi, class Sched>
__device__ __forceinline__ void gemm_phase(LAS unsigned char* lds, const Gemm g, const Sched& S, const Epi& E) {
    int tid = threadIdx.x; asm volatile("" : "+v"(tid));
    const int wid = __builtin_amdgcn_readfirstlane(tid >> 6), lane = tid & 63, wr = wid >> 2, wc = wid & 3, fr = lane & 15, fq = lane >> 4;
    const int K = g.K, nt = K / BK;
    unsigned voffA[2], voffB[2];
#pragma unroll
    for (int i = 0; i < 2; ++i) { int R, C; stage_rc(tid * 16 + i * 8192, R, C); const int Rb = Epi::PERM ? ((R & ~31) + perm32(R & 31)) : R;
        voffA[i] = (unsigned)(R * g.lda + C) * 2u; voffB[i] = (unsigned)(Rb * g.ldb + C) * 2u; }
    const size_t kstep = (size_t)(BK * 2);
    const size_t hstepA = (size_t)HALF * g.lda * 2, hstepB = (size_t)HALF * g.ldb * 2;
    const unsigned ldsw = (unsigned)wid * 1024u;
    const int aoff = lds_byte(wr * 64 + fr, fq * 8), boff = lds_byte(wc * 32 + fr, fq * 8);
#define PG8_SA(b, h) (((b) * 2 + (h)) * HTB)
#define PG8_SB(b, h) ((4 + (b) * 2 + (h)) * HTB)
#define PG8_STAGE(bufoff, gbase, voff) do { _Pragma("unroll") for (int _i = 0; _i < 2; ++_i) \
        __builtin_amdgcn_global_load_lds((const unsigned*)((const char*)(gbase) + (voff)[_i]), (LAS unsigned*)(lds + (bufoff) + ldsw + _i * 8192), 16, 0, 0); } while (0)
#define PG8_LDA(dst, b, h) do { _Pragma("unroll") for (int m = 0; m < 4; ++m) _Pragma("unroll") for (int k = 0; k < 2; ++k) dst[m][k] = *(const LAS bf16x8*)(lds + PG8_SA(b, h) + aoff + m * 2048 + k * 1024); } while (0)
#define PG8_LDB(dst, b, h) do { _Pragma("unroll") for (int n = 0; n < 2; ++n) _Pragma("unroll") for (int k = 0; k < 2; ++k) dst[n][k] = *(const LAS bf16x8*)(lds + PG8_SB(b, h) + boff + n * 2048 + k * 1024); } while (0)
#define PG8_MMA(ai, bj, At, Bt) do { __builtin_amdgcn_s_setprio(1); _Pragma("unroll") for (int m = 0; m < 4; ++m) _Pragma("unroll") for (int n = 0; n < 2; ++n) _Pragma("unroll") for (int k = 0; k < 2; ++k) \
        acc[ai][bj][m][n] = __builtin_amdgcn_mfma_f32_16x16x32_bf16(Bt[n][k], At[m][k], acc[ai][bj][m][n], 0, 0, 0); __builtin_amdgcn_s_setprio(0); } while (0)
#define PG8_WAIT_V(n) asm volatile("s_waitcnt vmcnt(" #n ")" ::: "memory")
#define PG8_WAIT_L(n) asm volatile("s_waitcnt lgkmcnt(" #n ")" ::: "memory")
#define PG8_BAR __builtin_amdgcn_s_barrier()
#define PG8_SCHED __builtin_amdgcn_sched_barrier(0)
    Unit cur, nxt; int ui = 0;
    if (!S.next(0, cur)) return;
    f32x4 acc[2][2][4][2];
#pragma unroll
    for (int a = 0; a < 2; ++a)
#pragma unroll
        for (int b = 0; b < 2; ++b)
#pragma unroll
            for (int m = 0; m < 4; ++m)
#pragma unroll
                for (int n = 0; n < 2; ++n) acc[a][b][m][n] = (f32x4){0.f, 0.f, 0.f, 0.f};
    bf16x8 At[4][2], B0[2][2], B1[2][2];
    const char* cA = S.a_base(cur); const char* cB = S.b_base(cur);
    PG8_STAGE(PG8_SB(0, 0), cB, voffB); PG8_STAGE(PG8_SB(0, 1), cB + hstepB, voffB); PG8_STAGE(PG8_SA(0, 0), cA, voffA); PG8_STAGE(PG8_SA(0, 1), cA + hstepA, voffA);
    if (wr == 1) PG8_BAR;
    PG8_WAIT_V(2); PG8_BAR;
    PG8_STAGE(PG8_SB(1, 0), cB + kstep, voffB); PG8_STAGE(PG8_SA(1, 0), cA + kstep, voffA); PG8_STAGE(PG8_SB(1, 1), cB + hstepB + kstep, voffB);
    PG8_WAIT_V(6); PG8_BAR;
    for (;;) {
        const bool has_next = S.next(ui + 1, nxt);
        const char* nA = has_next ? S.a_base(nxt) : cA; const char* nB = has_next ? S.b_base(nxt) : cB;
        for (int t = 0; t < nt; t += 2) {
            const bool last = (t == nt - 2);
            const char* a1 = cA + (size_t)(t + 1) * kstep;
            const char* a2 = last ? nA : cA + (size_t)(t + 2) * kstep; const char* b2 = last ? nB : cB + (size_t)(t + 2) * kstep;
            const char* a3 = a2 + kstep; const char* b3 = b2 + kstep;
            if constexpr (Epi::MID) { if (t == (nt >> 1)) E.mid(acc, cur, wr, wc, fr, fq); }
            PG8_LDB(B0, 0, 0); PG8_LDB(B1, 0, 1); PG8_SCHED; PG8_LDA(At, 0, 0); PG8_STAGE(PG8_SA(1, 1), a1 + hstepA, voffA);
            PG8_WAIT_V(8); PG8_WAIT_L(0); PG8_BAR; PG8_MMA(0, 0, At, B0); PG8_MMA(0, 1, At, B1); PG8_BAR; PG8_SCHED;
            PG8_LDA(At, 0, 1); PG8_STAGE(PG8_SB(0, 0), b2, voffB); PG8_STAGE(PG8_SB(0, 1), b2 + hstepB, voffB); PG8_STAGE(PG8_SA(0, 0), a2, voffA);
            PG8_WAIT_V(8); PG8_WAIT_L(0); PG8_BAR; PG8_MMA(1, 0, At, B0); PG8_MMA(1, 1, At, B1); PG8_BAR; PG8_SCHED;
            PG8_LDB(B0, 1, 0); PG8_LDB(B1, 1, 1); PG8_SCHED; PG8_LDA(At, 1, 0); PG8_STAGE(PG8_SA(0, 1), a2 + hstepA, voffA);
            PG8_WAIT_V(8); PG8_WAIT_L(0); PG8_BAR; PG8_MMA(0, 0, At, B0); PG8_MMA(0, 1, At, B1); PG8_BAR; PG8_SCHED;
            PG8_LDA(At, 1, 1); PG8_STAGE(PG8_SB(1, 0), b3, voffB); PG8_STAGE(PG8_SB(1, 1), b3 + hstepB, voffB); PG8_STAGE(PG8_SA(1, 0), a3, voffA);
            PG8_WAIT_V(8); PG8_WAIT_L(0); PG8_BAR; PG8_MMA(1, 0, At, B0); PG8_MMA(1, 1, At, B1); PG8_BAR; PG8_SCHED;
        }
        if (wr == 0) PG8_BAR;
        E(acc, cur, wr, wc, fr, fq);
        if (!has_next) break;
#pragma unroll
        for (int a = 0; a < 2; ++a)
#pragma unroll
            for (int b = 0; b < 2; ++b)
#pragma unroll
                for (int m = 0; m < 4; ++m)
#pragma unroll
                    for (int n = 0; n < 2; ++n) acc[a][b][m][n] = (f32x4){0.f, 0.f, 0.f, 0.f};
        cur = nxt; cA = nA; cB = nB; ++ui;
        if (wr == 1) PG8_BAR;
    }
    PG8_WAIT_V(0);
    PG8_BAR;
#undef PG8_SA
#undef PG8_SB
#undef PG8_STAGE
#undef PG8_LDA
#undef PG8_LDB
#undef PG8_MMA
#undef PG8_WAIT_V
#undef PG8_WAIT_L
#undef PG8_BAR
#undef PG8_SCHED
}

#define EPI_LOOP_HEAD \
    _Pragma("unroll") for (int ai = 0; ai < 2; ++ai) _Pragma("unroll") for (int m = 0; m < 4; ++m) { const int row = u.pm * BM + ai * HALF + wr * 64 + m * 16 + fr; \
    _Pragma("unroll") for (int bj = 0; bj < 2; ++bj) {
#define EPI_LOOP_TAIL } }
__device__ __forceinline__ u32x4 pack8(const f32x4& v0, const f32x4& v1) { u32x4 w; w.x = cvt_pk_bf16(v0[0], v0[1]); w.y = cvt_pk_bf16(v0[2], v0[3]); w.z = cvt_pk_bf16(v1[0], v1[1]); w.w = cvt_pk_bf16(v1[2], v1[3]); return w; }
__device__ __forceinline__ void unpack8(const u32x4& w, f32x4& v0, f32x4& v1) { v0 = (f32x4){bf_lo(w.x), bf_hi(w.x), bf_lo(w.y), bf_hi(w.y)}; v1 = (f32x4){bf_lo(w.z), bf_hi(w.z), bf_lo(w.w), bf_hi(w.w)}; }

struct EpiProj { static constexpr bool PERM = true, MID = false; bf16_t* UG; bf16_t* PROJ;
    __device__ __forceinline__ void operator()(const f32x4 (&acc)[2][2][4][2], const Unit& u, int wr, int wc, int fr, int fq) const {
        if (u.pn >= 4) {
#pragma unroll
            for (int ai = 0; ai < 2; ++ai)
#pragma unroll
                for (int m = 0; m < 4; ++m) { const int row = u.pm * BM + ai * HALF + wr * 64 + m * 16 + fr, ch = (u.pn - 4) * HALF + wc * 32 + 8 * fq;
                    f32x4 r0, r1, s0, s1;
#pragma unroll
                    for (int e = 0; e < 4; ++e) { const float eb0 = __expf(-fmaxf(acc[ai][1][m][0][e], -60.f)), eb1 = __expf(-fmaxf(acc[ai][1][m][1][e], -60.f));
                        r0[e] = (1.0f + eb0) * __builtin_amdgcn_rcpf(1.0f + __expf(-acc[ai][0][m][0][e])); r1[e] = (1.0f + eb1) * __builtin_amdgcn_rcpf(1.0f + __expf(-acc[ai][0][m][1][e]));
                        s0[e] = __builtin_amdgcn_rcpf(1.0f + eb0); s1[e] = __builtin_amdgcn_rcpf(1.0f + eb1); }
                    bf16_t* p = PROJ + (size_t)row * PROJ_LD + 512 + ch;
                    *(u32x4*)p = pack8(r0, r1); *(u32x4*)(p + 1024) = pack8(s0, s1); }
            return;
        }
        EPI_LOOP_HEAD
            const int col = u.pn * BM + bj * HALF + wc * 32 + 8 * fq;
            bf16_t* dst = (u.pn < 2) ? UG + ((size_t)((col >> 4) * NCHP + (row >> 4)) * UG_LD + (row & 15) * 16 + (col & 15)) : PROJ + (size_t)row * PROJ_LD + (col - 512);
            *(u32x4*)dst = pack8(acc[ai][bj][m][0], acc[ai][bj][m][1]);
        EPI_LOOP_TAIL
    } };
struct EpiE { static constexpr bool PERM = false, MID = false; float* E;
    __device__ __forceinline__ void operator()(const f32x4 (&acc)[2][2][4][2], const Unit& u, int wr, int wc, int fr, int fq) const {
        EPI_LOOP_HEAD
            float* p = E + ((size_t)u.g * NCHP + row) * 256 + bj * HALF + wc * 32 + 4 * fq;
            *(f32x4*)p = acc[ai][bj][m][0]; *(f32x4*)(p + 16) = acc[ai][bj][m][1];
        EPI_LOOP_TAIL
    } };
struct EpiY { static constexpr bool PERM = true, MID = false; bf16_t* Y;
    __device__ __forceinline__ void operator()(const f32x4 (&acc)[2][2][4][2], const Unit& u, int wr, int wc, int fr, int fq) const {
        EPI_LOOP_HEAD
            if (row < MTOK / 16) {
                const int n0 = bj * HALF + wc * 32 + 8 * fq, j = n0 >> 4, c0 = n0 & 15;
                f32x4 v0 = acc[ai][bj][m][0], v1 = acc[ai][bj][m][1];
#pragma unroll
                for (int e = 0; e < 4; ++e) { v0[e] = gelu_tanh(v0[e]); v1[e] = gelu_tanh(v1[e]); }
                *(u32x4*)(Y + (size_t)(row * 16 + j) * DS + u.g * 16 + c0) = pack8(v0, v1);
            }
        EPI_LOOP_TAIL
    } };
struct EpiGlu { static constexpr bool PERM = true, MID = false; const bf16_t* Y; bf16_t* Z; const float* bias;
    __device__ __forceinline__ void operator()(const f32x4 (&acc)[2][2][4][2], const Unit& u, int wr, int wc, int fr, int fq) const {
        const int col0 = u.pn * BM + wc * 32 + 8 * fq;
        f32x4 bv[2][2];
#pragma unroll
        for (int bj = 0; bj < 2; ++bj) { bv[bj][0] = *(const f32x4*)(bias + col0 + bj * HALF); bv[bj][1] = *(const f32x4*)(bias + col0 + bj * HALF + 4); }
#pragma unroll
        for (int ai = 0; ai < 2; ++ai) {
            u32x4 yw[4][2];
#pragma unroll
            for (int m = 0; m < 4; ++m)
#pragma unroll
                for (int bj = 0; bj < 2; ++bj) yw[m][bj] = *(const u32x4*)(Y + (size_t)(u.pm * BM + ai * HALF + wr * 64 + m * 16 + fr) * DS + col0 + bj * HALF);
#pragma unroll
            for (int m = 0; m < 4; ++m)
#pragma unroll
                for (int bj = 0; bj < 2; ++bj) { const int row = u.pm * BM + ai * HALF + wr * 64 + m * 16 + fr;
                    f32x4 y0, y1; unpack8(yw[m][bj], y0, y1);
                    f32x4 v0 = acc[ai][bj][m][0] + bv[bj][0], v1 = acc[ai][bj][m][1] + bv[bj][1];
#pragma unroll
                    for (int e = 0; e < 4; ++e) { v0[e] = y0[e] * sigmoidf_(v0[e]); v1[e] = y1[e] * sigmoidf_(v1[e]); }
                    *(u32x4*)(Z + (size_t)row * DM + col0 + bj * HALF) = pack8(v0, v1); }
        }
    } };
struct EpiMerged { static constexpr bool PERM = true, MID = true; const bf16_t* gates; bf16_t* O;
    __device__ __forceinline__ void mid(f32x4 (&acc)[2][2][4][2], const Unit& u, int wr, int wc, int fr, int fq) const {
        const int col0 = u.pn * BM + wc * 32 + 8 * fq;
#pragma unroll
        for (int ai = 0; ai < 2; ++ai) {
            u32x4 gw[4][2];
#pragma unroll
            for (int m = 0; m < 4; ++m)
#pragma unroll
                for (int bj = 0; bj < 2; ++bj) gw[m][bj] = *(const u32x4*)(gates + (size_t)(u.pm * BM + ai * HALF + wr * 64 + m * 16 + fr) * PROJ_LD + col0 + bj * HALF);
#pragma unroll
            for (int m = 0; m < 4; ++m)
#pragma unroll
                for (int bj = 0; bj < 2; ++bj) { f32x4 a0, a1; unpack8(gw[m][bj], a0, a1); acc[ai][bj][m][0] *= a0; acc[ai][bj][m][1] *= a1; }
        }
    }
    __device__ __forceinline__ void operator()(const f32x4 (&acc)[2][2][4][2], const Unit& u, int wr, int wc, int fr, int fq) const {
        const int col0 = u.pn * BM + wc * 32 + 8 * fq;
#pragma unroll
        for (int ai = 0; ai < 2; ++ai) {
            u32x4 gw[4][2];
#pragma unroll
            for (int m = 0; m < 4; ++m)
#pragma unroll
                for (int bj = 0; bj < 2; ++bj) gw[m][bj] = *(const u32x4*)(gates + (size_t)(u.pm * BM + ai * HALF + wr * 64 + m * 16 + fr) * PROJ_LD + col0 + bj * HALF + 1024);
#pragma unroll
            for (int m = 0; m < 4; ++m)
#pragma unroll
                for (int bj = 0; bj < 2; ++bj) { const int row = u.pm * BM + ai * HALF + wr * 64 + m * 16 + fr; f32x4 g0, g1; unpack8(gw[m][bj], g0, g1);
                    *(u32x4*)(O + (size_t)row * DM + col0 + bj * HALF) = pack8(acc[ai][bj][m][0] * g0, acc[ai][bj][m][1] * g1); }
        }
    } };
struct EpiResid { static constexpr bool PERM = false, MID = false; const float* base; float* out; const float* gvec;
    __device__ __forceinline__ void operator()(const f32x4 (&acc)[2][2][4][2], const Unit& u, int wr, int wc, int fr, int fq) const {
        EPI_LOOP_HEAD
            const int col = u.pn * BM + bj * HALF + wc * 32 + 4 * fq;
            const float* gv = gvec + (row >> 13) * 6144 + col;
            const size_t o = (size_t)row * DM + col;
            *(f32x4*)(out + o) = *(const f32x4*)(base + o) + *(const f32x4*)gv * acc[ai][bj][m][0];
            *(f32x4*)(out + o + 16) = *(const f32x4*)(base + o + 16) + *(const f32x4*)(gv + 16) * acc[ai][bj][m][1];
        EPI_LOOP_TAIL
    } };
struct EpiResidB { static constexpr bool PERM = true, MID = false; const bf16_t* base; float* out; const float* gvec;
    __device__ __forceinline__ void operator()(const f32x4 (&acc)[2][2][4][2], const Unit& u, int wr, int wc, int fr, int fq) const {
        EPI_LOOP_HEAD
            const int col = u.pn * BM + bj * HALF + wc * 32 + 8 * fq; const float* gv = gvec + (row >> 13) * 6144 + col; float* op = out + (size_t)row * DM + col;
            f32x4 b0, b1; unpack8(*(const u32x4*)(base + (size_t)row * DM + col), b0, b1);
            *(f32x4*)op = b0 + *(const f32x4*)gv * acc[ai][bj][m][0]; *(f32x4*)(op + 4) = b1 + *(const f32x4*)(gv + 4) * acc[ai][bj][m][1];
        EPI_LOOP_TAIL
    } };
struct EpiSwiglu { static constexpr bool PERM = true, MID = false; bf16_t* O;
    __device__ __forceinline__ void operator()(const f32x4 (&acc)[2][2][4][2], const Unit& u, int wr, int wc, int fr, int fq) const {
#pragma unroll
        for (int ai = 0; ai < 2; ++ai)
#pragma unroll
            for (int m = 0; m < 4; ++m) { const int row = u.pm * BM + ai * HALF + wr * 64 + m * 16 + fr;
                f32x4 v0 = acc[ai][0][m][0], v1 = acc[ai][0][m][1];
#pragma unroll
                for (int e = 0; e < 4; ++e) { v0[e] = v0[e] * sigmoidf_(v0[e]) * acc[ai][1][m][0][e]; v1[e] = v1[e] * sigmoidf_(v1[e]) * acc[ai][1][m][1][e]; }
                *(u32x4*)(O + (size_t)row * FF + u.pn * HALF + wc * 32 + 8 * fq) = pack8(v0, v1); }
    } };
struct EpiResidNorm { static constexpr bool PERM = true, MID = false; const float* x; float* X1; const float* mod; const float* gam; bf16_t* H2; float* rowss4; LAS float* part;
    __device__ __forceinline__ void operator()(const f32x4 (&acc)[2][2][4][2], const Unit& u, int wr, int wc, int fr, int fq) const {
        const int col0 = u.pn * BM + wc * 32 + 8 * fq; const float* mb = mod + ((u.pm * BM) >> 13) * 6144;
        f32x4 g1v[2][2], hv[2][2];
#pragma unroll
        for (int bj = 0; bj < 2; ++bj)
#pragma unroll
            for (int n = 0; n < 2; ++n) { const int c = col0 + bj * HALF + 4 * n; g1v[bj][n] = *(const f32x4*)(mb + 2048 + c); hv[bj][n] = *(const f32x4*)(gam + c) * (*(const f32x4*)(mb + 4096 + c) + 1.0f); }
#pragma unroll
        for (int ai = 0; ai < 2; ++ai)
#pragma unroll
            for (int mh = 0; mh < 2; ++mh) {
                f32x4 xv[2][2][2];
#pragma unroll
                for (int mm = 0; mm < 2; ++mm)
#pragma unroll
                    for (int bj = 0; bj < 2; ++bj) { const float* xp = x + (size_t)(u.pm * BM + ai * HALF + wr * 64 + (mh * 2 + mm) * 16 + fr) * DM + col0 + bj * HALF; xv[mm][bj][0] = ld_nt(xp); xv[mm][bj][1] = ld_nt(xp + 4); }
#pragma unroll
                for (int mm = 0; mm < 2; ++mm) { const int m = mh * 2 + mm, row = u.pm * BM + ai * HALF + wr * 64 + m * 16 + fr; float ss = 0.f;
#pragma unroll
                    for (int bj = 0; bj < 2; ++bj) { const size_t o = (size_t)row * DM + col0 + bj * HALF;
                        const f32x4 x0 = xv[mm][bj][0] + g1v[bj][0] * acc[ai][bj][m][0], x1 = xv[mm][bj][1] + g1v[bj][1] * acc[ai][bj][m][1];
                        ss += ((x0.x * x0.x + x0.y * x0.y) + (x0.z * x0.z + x0.w * x0.w)) + ((x1.x * x1.x + x1.y * x1.y) + (x1.z * x1.z + x1.w * x1.w));
                        *(f32x4*)(X1 + o) = x0; *(f32x4*)(X1 + o + 4) = x1;
                        *(u32x4*)(H2 + o) = pack8(x0 * hv[bj][0], x1 * hv[bj][1]); }
                    ss += swz_xor<16>(ss); ss += xor32(ss, fq * 16 + fr);
                    if (fq == 0) part[(ai * HALF + wr * 64 + m * 16 + fr) * 4 + wc] = ss; }
            }
        asm volatile("s_waitcnt lgkmcnt(0)" ::: "memory");
        __builtin_amdgcn_s_barrier();
        asm volatile("" ::: "memory");
        { const int t = (wr * 4 + wc) * 64 + fq * 16 + fr;
          if (t < 256) { const f32x4 p4 = *(const LAS f32x4*)(part + t * 4); rowss4[(size_t)(u.pm * BM + t) * 4 + u.pn] = (p4.x + p4.y) + (p4.z + p4.w); } }
    } };
struct EpiSwigluN { static constexpr bool PERM = true, MID = false; bf16_t* O; const float* rowss; const float* bias2;
    __device__ __forceinline__ void operator()(const f32x4 (&acc)[2][2][4][2], const Unit& u, int wr, int wc, int fr, int fq) const {
        const float* bb = bias2 + ((u.pm * BM) >> 13) * (2 * FF) + u.pn * BM + wc * 32 + 8 * fq;
        const f32x4 bg0 = *(const f32x4*)bb, bg1 = *(const f32x4*)(bb + 4), bu0 = *(const f32x4*)(bb + HALF), bu1 = *(const f32x4*)(bb + HALF + 4);
        float rs[8];
#pragma unroll
        for (int k = 0; k < 8; ++k) { const f32x4 p4 = *(const f32x4*)(rowss + (size_t)(u.pm * BM + (k >> 2) * HALF + wr * 64 + (k & 3) * 16 + fr) * 4); rs[k] = (p4.x + p4.y) + (p4.z + p4.w); }
#pragma unroll
        for (int k = 0; k < 8; ++k) rs[k] = __builtin_amdgcn_rsqf(rs[k] * (1.0f / DM) + RMS_EPS);
#pragma unroll
        for (int ai = 0; ai < 2; ++ai)
#pragma unroll
            for (int m = 0; m < 4; ++m) { const int row = u.pm * BM + ai * HALF + wr * 64 + m * 16 + fr; const float rstd = rs[ai * 4 + m];
                f32x4 g0 = acc[ai][0][m][0] * rstd + bg0, g1 = acc[ai][0][m][1] * rstd + bg1;
                const f32x4 u0 = acc[ai][1][m][0] * rstd + bu0, u1 = acc[ai][1][m][1] * rstd + bu1;
#pragma unroll
                for (int e = 0; e < 4; ++e) { g0[e] = g0[e] * sigmoidf_(g0[e]) * u0[e]; g1[e] = g1[e] * sigmoidf_(g1[e]) * u1[e]; }
                *(u32x4*)(O + (size_t)row * FF + u.pn * HALF + wc * 32 + 8 * fq) = pack8(g0, g1); }
    } };
struct EpiResidFinal { static constexpr bool PERM = true, MID = false; float* out; const float* gvec; const float* fg; float* rowss; unsigned* pcnt;
    __device__ __forceinline__ void operator()(f32x4 (&acc)[2][2][4][2], const Unit& u, int wr, int wc, int fr, int fq) const {
        const int col0 = u.pn * BM + wc * 32 + 8 * fq; const float* gv = gvec + ((u.pm * BM) >> 13) * 6144;
        f32x4 g2v[2][2];
#pragma unroll
        for (int bj = 0; bj < 2; ++bj)
#pragma unroll
            for (int n = 0; n < 2; ++n) g2v[bj][n] = *(const f32x4*)(gv + col0 + bj * HALF + 4 * n);
#pragma unroll
        for (int ai = 0; ai < 2; ++ai)
#pragma unroll
            for (int mh = 0; mh < 2; ++mh) {
                f32x4 xv[2][2][2];
#pragma unroll
                for (int mm = 0; mm < 2; ++mm)
#pragma unroll
                    for (int bj = 0; bj < 2; ++bj) { const float* bp = out + (size_t)(u.pm * BM + ai * HALF + wr * 64 + (mh * 2 + mm) * 16 + fr) * DM + col0 + bj * HALF; xv[mm][bj][0] = *(const f32x4*)bp; xv[mm][bj][1] = *(const f32x4*)(bp + 4); }
#pragma unroll
                for (int mm = 0; mm < 2; ++mm) { const int m = mh * 2 + mm, row = u.pm * BM + ai * HALF + wr * 64 + m * 16 + fr; float ss = 0.f;
#pragma unroll
                    for (int bj = 0; bj < 2; ++bj) {
                        const f32x4 x0 = xv[mm][bj][0] + g2v[bj][0] * acc[ai][bj][m][0], x1 = xv[mm][bj][1] + g2v[bj][1] * acc[ai][bj][m][1];
                        acc[ai][bj][m][0] = x0; acc[ai][bj][m][1] = x1;
                        ss += ((x0.x * x0.x + x0.y * x0.y) + (x0.z * x0.z + x0.w * x0.w)) + ((x1.x * x1.x + x1.y * x1.y) + (x1.z * x1.z + x1.w * x1.w)); }
                    ss += swz_xor<16>(ss); ss += xor32(ss, fq * 16 + fr);
                    if (fq == 0) atomicAdd(rowss + row, ss); }
            }
        f32x4 fgv[2][2];
#pragma unroll
        for (int bj = 0; bj < 2; ++bj)
#pragma unroll
            for (int n = 0; n < 2; ++n) fgv[bj][n] = *(const f32x4*)(fg + col0 + bj * HALF + 4 * n);
        asm volatile("s_waitcnt vmcnt(0)" ::: "memory");
        __builtin_amdgcn_s_barrier();
        if (threadIdx.x == 0) {
            unsigned* pc = pcnt + 64 * u.pm;
            __hip_atomic_fetch_add(pc, 1u, __ATOMIC_RELAXED, __HIP_MEMORY_SCOPE_AGENT);
            unsigned sp = 0;
            while (__hip_atomic_load(pc, __ATOMIC_RELAXED, __HIP_MEMORY_SCOPE_AGENT) < 4u) { __builtin_amdgcn_s_sleep(1); if (++sp > (1u << 22)) break; }
        }
        __builtin_amdgcn_s_barrier();
        asm volatile("" ::: "memory");
        float rs[8];
#pragma unroll
        for (int k = 0; k < 8; ++k) rs[k] = __hip_atomic_load(rowss + u.pm * BM + (k >> 2) * HALF + wr * 64 + (k & 3) * 16 + fr, __ATOMIC_RELAXED, __HIP_MEMORY_SCOPE_AGENT);
#pragma unroll
        for (int k = 0; k < 8; ++k) rs[k] = __builtin_amdgcn_rsqf(rs[k] * (1.0f / DM) + RMS_EPS);
#pragma unroll
        for (int ai = 0; ai < 2; ++ai)
#pragma unroll
            for (int m = 0; m < 4; ++m) { const int row = u.pm * BM + ai * HALF + wr * 64 + m * 16 + fr; const float rstd = rs[ai * 4 + m];
#pragma unroll
                for (int bj = 0; bj < 2; ++bj) { float* op = out + (size_t)row * DM + col0 + bj * HALF;
                    st_nt(op, acc[ai][bj][m][0] * rstd * fgv[bj][0]); st_nt(op + 4, acc[ai][bj][m][1] * rstd * fgv[bj][1]); } }
    } };
}

#define XB_TMO      128
#define XB_XCNT(j)  (256  + 64 * (j))
#define XB_XSUB(j)  (1280 + 64 * (j))
#define XB_XGEN(j)  (2304 + 64 * (j))
#define XB_TOP      3328
#define XB_TOPGEN   3392
#define XCD_BAR_WORDS 3456
#define XB_SPIN_CAP (1u << 22)
__device__ __forceinline__ unsigned xb_ld(unsigned* p)              { return __hip_atomic_load(p, __ATOMIC_RELAXED, __HIP_MEMORY_SCOPE_AGENT); }
__device__ __forceinline__ unsigned xb_add(unsigned* p, unsigned v) { return __hip_atomic_fetch_add(p, v, __ATOMIC_RELAXED, __HIP_MEMORY_SCOPE_AGENT); }
__device__ __forceinline__ unsigned xb_xcc_id() { return (unsigned)__builtin_amdgcn_s_getreg((3 << 11) | 20) & 0xFu; }
#define XB_SPIN(cond, bar) do { unsigned _sp = 0; while (cond) { __builtin_amdgcn_s_sleep(1); \
    if ((++_sp & 255u) == 0u) { if (xb_ld(&(bar)[XB_TMO])) break; if (_sp > XB_SPIN_CAP) { atomicAdd(&(bar)[XB_TMO], 1u); break; } } } } while (0)
struct XcdBarrier { unsigned* bar; unsigned x; volatile LAS unsigned* st; unsigned gsize; };
__device__ __forceinline__ XcdBarrier xcd_barrier_post(unsigned* bar, volatile LAS unsigned* st, unsigned gsize) {
    XcdBarrier b; b.bar = bar; b.x = xb_xcc_id(); b.st = st; b.gsize = gsize;
    if (threadIdx.x == 0) (void)xb_add(&bar[XB_XCNT(b.x)], 1u);
    return b;
}
__device__ __forceinline__ void xcd_barrier_complete(unsigned* bar, unsigned x, unsigned& nloc, unsigned& nx, const unsigned G) {
    unsigned sum, cnt, mine, sp = 0u;
    for (;;) {
        sum = 0u; cnt = 0u; mine = 0u;
#pragma unroll
        for (unsigned j = 0; j < 16; ++j) { const unsigned c = xb_ld(&bar[XB_XCNT(j)]); sum += c; cnt += (c > 0u) ? 1u : 0u; mine = (j == x) ? c : mine; }
        if (sum == G) break;
        __builtin_amdgcn_s_sleep(1);
        if ((++sp & 255u) == 0u) { if (xb_ld(&bar[XB_TMO])) break; if (sp > XB_SPIN_CAP) { atomicAdd(&bar[XB_TMO], 1u); break; } }
    }
    nloc = mine > 0u ? mine : 1u; nx = cnt > 0u ? cnt : 1u;
}
__device__ __forceinline__ void xcd_barrier(const XcdBarrier& b) {
    asm volatile("s_waitcnt vmcnt(0)" ::: "memory");
    __syncthreads();
    if (threadIdx.x == 0) {
        unsigned* bar = b.bar;
        __builtin_amdgcn_s_waitcnt(0);
        unsigned nloc = b.st[0], nx = b.st[1];
        if (nloc == 0u) { xcd_barrier_complete(bar, b.x, nloc, nx, b.gsize); b.st[0] = nloc; b.st[1] = nx; }
        const unsigned old = xb_add(&bar[XB_XSUB(b.x)], 1u);
        const unsigned gen = old / nloc;
        if (old + 1u == (gen + 1u) * nloc) {
            __builtin_amdgcn_fence(__ATOMIC_RELEASE, "agent");
            asm volatile("s_waitcnt vmcnt(0)" ::: "memory");
            const unsigned og = xb_add(&bar[XB_TOP], 1u);
            const unsigned tg = og / nx;
            if (og + 1u == (tg + 1u) * nx) xb_add(&bar[XB_TOPGEN], 1u);
            else XB_SPIN(xb_ld(&bar[XB_TOPGEN]) == tg, bar);
            __builtin_amdgcn_fence(__ATOMIC_ACQUIRE, "agent");
            xb_add(&bar[XB_XGEN(b.x)], 1u);
            asm volatile("s_waitcnt vmcnt(0)" ::: "memory");
        } else {
            XB_SPIN(xb_ld(&bar[XB_XGEN(b.x)]) == gen, bar);
            __builtin_amdgcn_fence(__ATOMIC_ACQUIRE, "agent");
            asm volatile("s_waitcnt vmcnt(0)" ::: "memory");
        }
    }
    __syncthreads();
}

struct Args { const float* in[27]; float* out; unsigned char* ws; };
#define KAS __attribute__((address_space(4)))
__device__ __forceinline__ const KAS char* karg_ptr() { const KAS char* kp = (const KAS char*)__builtin_amdgcn_kernarg_segment_ptr(); asm volatile("" : "+s"(kp)); return kp; }
__device__ __forceinline__ const float* AIN(int k) { return *(const float* const KAS*)(karg_ptr() + 8 * k); }
__device__ __forceinline__ float* AOUT() { return *(float* const KAS*)(karg_ptr() + 8 * 27); }
__device__ __forceinline__ unsigned char* AWS() { return *(unsigned char* const KAS*)(karg_ptr() + 8 * 28); }

__device__ __forceinline__ void transpose_item(const float* W, int N, bf16_t* WT, int ldt, int dest_row0, int k0, int n0, LAS float* scr, int lane) {
#pragma unroll 8
    for (int i = 0; i < 32; ++i) { const int kk = 2 * i + (lane >> 5); scr[kk * 33 + (lane & 31)] = W[(size_t)(k0 + kk) * N + n0 + (lane & 31)]; }
    asm volatile("s_waitcnt lgkmcnt(0)" ::: "memory");
    const int c = lane & 7;
#pragma unroll
    for (int j = 0; j < 4; ++j) { const int n = (lane >> 3) + 8 * j; const LAS float* s = scr + (8 * c) * 33 + n;
        u32x4 o; o.x = cvt_pk_bf16(s[0 * 33], s[1 * 33]); o.y = cvt_pk_bf16(s[2 * 33], s[3 * 33]); o.z = cvt_pk_bf16(s[4 * 33], s[5 * 33]); o.w = cvt_pk_bf16(s[6 * 33], s[7 * 33]);
        *(u32x4*)(WT + (size_t)(dest_row0 + n) * ldt + k0 + 8 * c) = o; }
    asm volatile("s_waitcnt lgkmcnt(0)" ::: "memory");
}

__device__ __forceinline__ void norm_mod_row(const float* xrow, const float* gam, const float* sh, const float* sc, bf16_t* orow, int lane) {
    f32x4 v[4]; float s = 0.f;
#pragma unroll
    for (int j = 0; j < 4; ++j) { v[j] = ((const f32x4*)xrow)[lane + 64 * j]; s += (v[j].x * v[j].x + v[j].y * v[j].y) + (v[j].z * v[j].z + v[j].w * v[j].w); }
    const float rstd = __builtin_amdgcn_rsqf(wave_sum(s) * (1.0f / DM) + RMS_EPS);
#pragma unroll
    for (int j = 0; j < 4; ++j) { const int ci = lane + 64 * j; const f32x4 g = ((const f32x4*)gam)[ci], a = ((const f32x4*)sc)[ci], b = ((const f32x4*)sh)[ci];
        const f32x4 h = (v[j] * rstd * g) * (a + 1.0f) + b;
        u32x2 o; o.x = cvt_pk_bf16(h.x, h.y); o.y = cvt_pk_bf16(h.z, h.w); ((u32x2*)orow)[ci] = o; }
}

template <int W> __device__ __forceinline__ void pool_column(LAS bf16_t* col) {
    float u[64], cs[65];
    cs[0] = 0.f;
#pragma unroll
    for (int q = 0; q < 64; ++q) { u[q] = __uint_as_float((unsigned)col[q * 512] << 16); cs[q + 1] = cs[q] + u[q]; }
#pragma unroll
    for (int q = 0; q < 64; ++q) {
        constexpr int dummy = 0; (void)dummy;
        const int lo = (q - W / 2) < 0 ? 0 : (q - W / 2); int hi = q + W - 1 - W / 2; hi = (hi > 63 ? 63 : hi) + 1;
        const float mean = (cs[hi] - cs[lo]) * (1.0f / (float)(hi - lo));
        col[q * 512] = (bf16_t)(cvt_pk_bf16(mean - u[q], 0.f) & 0xffffu);
    }
}

#define modx ((float*)(ws + 65536))
#define modc ((float*)(ws + 65536 + 49152))
#define ATg ((float*)(ws + WS_MOD + 131072))
#define Win_t ((bf16_t*)(ws + WS_WIN))
#define Wglu_t ((bf16_t*)(ws + WS_WGLU))
#define Wcat_t ((bf16_t*)(ws + WS_WA))
#define Wout_t ((bf16_t*)(ws + WS_WOUT))
#define Wffi_t ((bf16_t*)(ws + WS_WFFI))
#define Wffo_t ((bf16_t*)(ws + WS_WFFO))
#define W1_t ((bf16_t*)(ws + WS_W1))
#define W2_t ((bf16_t*)(ws + WS_W2))
#define H ((bf16_t*)(ws + WS_H))
#define PROJ ((bf16_t*)(ws + WS_PROJ))
#define AFFN ((bf16_t*)(ws + WS_PROJ))
#define UG ((bf16_t*)(ws + WS_UG))
#define ZD ((bf16_t*)(ws + WS_UG))
#define Y ((bf16_t*)(ws + WS_Y))
#define H2 ((bf16_t*)(ws + WS_DP))
#define X1B ((bf16_t*)(ws + WS_UG))
#define BIAS2 ((float*)(ws + WS_MOD + 196608))
#define ROWSS ((float*)(ws + 131072))
#define ROWSS4 ((float*)(ws + WS_MOD + 262144))
#define ROWSS2 ((float*)(ws + 196608))
#define PCNT ((unsigned*)(ws + 262144))

constexpr int I_IN = 16 * 12, I_GLU = 8 * 2, I_A = 8 * 4, I_OUT = 16 * 4, I_FFI = 16 * 22, I_FFO = 44 * 4;
constexpr int I_EARLY = I_IN + I_GLU + I_A + I_OUT, I_LATE = I_FFI + I_FFO;
__device__ __forceinline__ void copy_item(int r, LAS unsigned char* lds, unsigned char* ws, int tid) {
    const float* W; int N, ldt, kb, nb, perm = 0; bf16_t* WT;
    if (r < I_IN) { W = AIN(8); N = 3072; WT = Win_t; ldt = 1024; kb = r / 12; nb = r % 12; perm = 2; }
    else if ((r -= I_IN) < I_GLU) { W = AIN(17); N = 512; WT = Wglu_t; ldt = 512; kb = r / 2; nb = r % 2; }
    else if ((r -= I_GLU) < I_A) { W = AIN(21); N = 1024; WT = Wcat_t; ldt = 1024; kb = r / 4; nb = r % 4; }
    else if ((r -= I_A) < I_OUT) { W = AIN(23); N = 1024; WT = Wout_t; ldt = 1024; kb = r / 4; nb = r % 4; }
    else if ((r -= I_OUT) < I_FFI) { W = AIN(24); N = 2 * FF; WT = Wffi_t; ldt = 1024; kb = r / 22; nb = r % 22; perm = 1; }
    else { r -= I_FFI; W = AIN(25); N = 1024; WT = Wffo_t; ldt = FF; kb = r / 4; nb = r % 4; }
    const int k0 = kb * 64, n0 = nb * 256;
    LAS unsigned* tile = (LAS unsigned*)lds;
    f32x4 v[8];
#pragma unroll
    for (int rr = 0; rr < 8; ++rr) { const int flat = rr * 512 + tid, k = flat >> 6, c4 = flat & 63; v[rr] = ld_nt(W + (size_t)(k0 + k) * N + n0 + c4 * 4); }
#pragma unroll
    for (int rr = 0; rr < 8; ++rr) { const int flat = rr * 512 + tid, k = flat >> 6, c4 = flat & 63;
        tile[k * 129 + c4 * 2] = cvt_pk_bf16(v[rr].x, v[rr].y); tile[k * 129 + c4 * 2 + 1] = cvt_pk_bf16(v[rr].z, v[rr].w); }
    __syncthreads();
#pragma unroll
    for (int i = 0; i < 2; ++i) { const int task = tid + 512 * i, kc = task & 7, np = task >> 3; unsigned w[8];
#pragma unroll
        for (int e = 0; e < 8; ++e) w[e] = tile[(8 * kc + e) * 129 + np];
        u32x4 lo, hi;
        lo.x = __builtin_amdgcn_perm(w[1], w[0], 0x05040100u); lo.y = __builtin_amdgcn_perm(w[3], w[2], 0x05040100u); lo.z = __builtin_amdgcn_perm(w[5], w[4], 0x05040100u); lo.w = __builtin_amdgcn_perm(w[7], w[6], 0x05040100u);
        hi.x = __builtin_amdgcn_perm(w[1], w[0], 0x07060302u); hi.y = __builtin_amdgcn_perm(w[3], w[2], 0x07060302u); hi.z = __builtin_amdgcn_perm(w[5], w[4], 0x07060302u); hi.w = __builtin_amdgcn_perm(w[7], w[6], 0x07060302u);
        const int n = n0 + 2 * np; int drow = n;
        if (perm == 1) { const int nn = n < FF ? n : n - FF; drow = 256 * (nn >> 7) + (n < FF ? 0 : 128) + (nn & 127); }
        else if (perm == 2 && n >= 1024) { const int isb = (n - 1024) >> 10, ch = (n - 1024) & 1023; drow = 1024 + 256 * (ch >> 7) + isb * 128 + (ch & 127); }
        bf16_t* dst = WT + (size_t)drow * ldt + k0 + 8 * kc;
        *(u32x4*)dst = lo; *(u32x4*)(dst + ldt) = hi; }
    __syncthreads();
}
__device__ __forceinline__ void late_copies(int cap, LAS unsigned char* lds, unsigned char* ws) {
    unsigned* qctr = (unsigned*)(ws + WS_CTL) + CW_QUEUE + 2048;
    volatile LAS unsigned* qw = (volatile LAS unsigned*)(lds + MISC_OFF) + 16;
    for (int i = 0; i < cap; ++i) {
        int tid = threadIdx.x; asm volatile("" : "+v"(tid));
        if (tid == 0) *qw = atomicAdd(qctr, 1u);
        __syncthreads();
        const int it = (int)*qw;
        __syncthreads();
        if (it >= I_LATE) break;
        copy_item(I_EARLY + it, lds, ws, tid);
    }
}

__global__ void __launch_bounds__(512, 2) mega_fwd(Args args) {
    extern __shared__ __attribute__((aligned(16))) unsigned char lds_raw[];
    LAS unsigned char* lds = (LAS unsigned char*)lds_raw;
#define PHASE_IDS() int tid = threadIdx.x; asm volatile("" : "+v"(tid)); const int lane = tid & 63, wave = __builtin_amdgcn_readfirstlane(tid >> 6); (void)lane; (void)wave
    const int G = gridDim.x, bid = blockIdx.x;
    for (int u = threadIdx.x; u < (LDS_BYTES - LDSCTL_OFF) / 4; u += 512) ((LAS unsigned*)(lds + LDSCTL_OFF))[u] = 0u;
    __syncthreads();
    { unsigned* z = (unsigned*)(AWS() + 131072); for (int i = bid * 512 + threadIdx.x; i < (278528 - 131072) / 4; i += G * 512) z[i] = 0u; }
    XcdBarrier bar = xcd_barrier_post((unsigned*)(AWS() + WS_CTL) + CW_BAR, (volatile LAS unsigned*)(lds + MISC_OFF) + 8, (unsigned)G);
    constexpr int NS = 160; const bool teams = (G == 256);
    XcdBarrier tbar = bar;
    if (teams && bid < NS) tbar = xcd_barrier_post((unsigned*)(AWS() + WS_CTL) + CW_BAR2, (volatile LAS unsigned*)(lds + MISC_OFF) + 10, (unsigned)NS);
#define GRID_BAR() xcd_barrier(bar)

    _Pragma("unroll") for (int rep_ = 0; rep_ < (int)((DUP_MASK >> 0) & 1u) + 1; ++rep_) {
    {
        LAS float* fl = (LAS float*)lds;
        unsigned char* ws = AWS();
        unsigned* qctr = (unsigned*)(ws + WS_CTL) + CW_QUEUE + 64 * rep_;
        volatile LAS unsigned* qw = (volatile LAS unsigned*)(lds + MISC_OFF) + 16;
        constexpr int Q_S5 = 128, Q_WPB = 64, Q_GEMV = 256;
        const bool defer = teams;
        const int I_COPY = defer ? I_EARLY : I_EARLY + I_LATE; constexpr int Q_NORM = MALL / 64;
        const int NITEMS = Q_S5 + Q_WPB + Q_GEMV + I_COPY + Q_NORM;
        unsigned* gemv_done = (unsigned*)(ws + WS_CTL) + CW_QUEUE + 1024;
        bool mod_ready = false;
        unsigned pre = (threadIdx.x == 0) ? atomicAdd(qctr, 1u) : 0u;
        for (;;) {
            PHASE_IDS();
            if (tid == 0) *qw = pre;
            __syncthreads();
            int it = (int)*qw;
            if (tid == 0 && it < NITEMS) pre = atomicAdd(qctr, 1u);
            __syncthreads();
            if (it >= NITEMS) break;
            it = it < Q_GEMV ? it + Q_S5 + Q_WPB : (it < Q_GEMV + Q_S5 + Q_WPB ? it - Q_GEMV : it);
            if (it < Q_S5) {
                const int g = it >> 2, part = it & 3;
                const float* a_re = AIN(9); const float* a_im = AIN(10); const float* log_dt = AIN(11);
                const float* b_re = AIN(12); const float* b_im = AIN(13); const float* c_re = AIN(14); const float* c_im = AIN(15); const float* s5_d = AIN(16);
                LAS float* AP = fl;
                LAS float* BB = fl + 4480;
                LAS float* CC = fl + 8576;
                LAS float* KD = fl + 12800;
                LAS float* CF = fl + 20992;
                {
                    const int d1 = (tid >> 6) & 1, p1 = tid & 63, eg = tid >> 7, gi1 = (d1 * 32 + g) * 64 + p1;
                    const float are = a_re[gi1], aim = a_im[gi1], ldt = log_dt[d1 * 32 + g];
                    float bre[4], bim[4];
#pragma unroll
                    for (int i = 0; i < 4; ++i) { const int idx = tid + 512 * i, d = idx >> 10, p = (idx >> 4) & 63, c = idx & 15; const size_t gx = (size_t)((d * 32 + g) * 64 + p) * 16 + c; bre[i] = b_re[gx]; bim[i] = b_im[gx]; }
#pragma unroll
                    for (int i = 0; i < 4; ++i) { const int idx = tid + 512 * i, d = idx >> 10, c = (idx >> 6) & 15, p = idx & 63; const int cidx = ((d * 32 + g) * 16 + c) * 64 + p;
                        CC[(d * 16 + c) * 130 + p * 2] = c_re[cidx]; CC[(d * 16 + c) * 130 + p * 2 + 1] = c_im[cidx]; }
                    const float dt = expf(ldt), xr = dt * are, yi = dt * aim;
#pragma unroll
                    for (int i = 0; i < 5; ++i) { const int e = eg + 4 * i;
                        if (e <= 16) { const float mag = expf((float)e * xr); float sn, cs; sincosf((float)e * yi, &sn, &cs);
                            AP[(d1 * 17 + e) * 130 + p1 * 2] = mag * cs; AP[(d1 * 17 + e) * 130 + p1 * 2 + 1] = mag * sn;
                            if (e == 16 && part == 0) { ATg[((g * 2 + d1) * 64 + p1) * 2] = mag * cs; ATg[((g * 2 + d1) * 64 + p1) * 2 + 1] = mag * sn; } } }
                    if (eg == 0) {
                        float sn, cs; sincosf(yi, &sn, &cs); const float sh = sinf(0.5f * yi);
                        const float nr = expm1f(xr) * cs - 2.0f * sh * sh, ni = expf(xr) * sn;
                        const float den = are * are + aim * aim;
                        CF[(d1 * 64 + p1) * 2] = (nr * are + ni * aim) / den; CF[(d1 * 64 + p1) * 2 + 1] = (ni * are - nr * aim) / den;
                    }
                    __syncthreads();
#pragma unroll
                    for (int i = 0; i < 4; ++i) { const int idx = tid + 512 * i, d = idx >> 10, p = (idx >> 4) & 63, c = idx & 15; const float cr = CF[(d * 64 + p) * 2], ci = CF[(d * 64 + p) * 2 + 1];
                        BB[((d * 64 + p) * 16 + c) * 2] = cr * bre[i] - ci * bim[i]; BB[((d * 64 + p) * 16 + c) * 2 + 1] = cr * bim[i] + ci * bre[i]; }
                }
                __syncthreads();
                {
                    const int ci = lane & 15, kq = lane >> 4;
                    for (int t = 0; t < 4; ++t) { const int mt = wave * 4 + t, d = mt >> 4, dl = mt & 15;
                        f32x4 kacc = {0.f, 0.f, 0.f, 0.f};
#pragma unroll 8
                        for (int ks = 0; ks < 32; ++ks) { const int p = 2 * ks + (kq >> 1);
                            const f32x2 cv = *(const LAS f32x2*)(CC + (d * 16 + ci) * 130 + p * 2), av = *(const LAS f32x2*)(AP + (d * 17 + dl) * 130 + p * 2);
                            const float av_ = (kq & 1) ? -(cv.x * av.y + cv.y * av.x) : (cv.x * av.x - cv.y * av.y);
                            const float bv_ = BB[((d * 64 + p) * 16 + ci) * 2 + (kq & 1)];
                            kacc = __builtin_amdgcn_mfma_f32_16x16x4f32(av_, bv_, kacc, 0, 0, 0); }
#pragma unroll
                        for (int rg = 0; rg < 4; ++rg) KD[((d * 16 + dl) * 16 + kq * 4 + rg) * 16 + ci] = kacc[rg]; }
                }
                __syncthreads();
                for (int q = tid; q < 64 * 64; q += 512) {
                    const int n = part * 64 + (q >> 6), k0 = (q & 63) * 8, j = n >> 4, c = n & 15; float v[8];
                    if (k0 < 256) { const int i = k0 >> 4, c20 = k0 & 15;
#pragma unroll
                        for (int e = 0; e < 8; ++e) { const int c2 = c20 + e;
                            v[e] = (i < j) ? KD[((0 * 16 + (j - i)) * 16 + c) * 16 + c2] : (i > j) ? KD[((1 * 16 + (i - j)) * 16 + c) * 16 + c2]
                                 : KD[((0 * 16 + 0) * 16 + c) * 16 + c2] + KD[((1 * 16 + 0) * 16 + c) * 16 + c2] + (c == c2 ? s5_d[g * 16 + c] : 0.f); }
                    } else { const int k2 = k0 - 256, d = k2 >> 7, ri = (k2 >> 6) & 1, p0 = k2 & 63, ex = d == 0 ? j + 1 : 16 - j;
#pragma unroll
                        for (int e = 0; e < 8; ++e) { const int p = p0 + e; const float cr = CC[(d * 16 + c) * 130 + p * 2], ci = CC[(d * 16 + c) * 130 + p * 2 + 1];
                            const float ar = AP[(d * 17 + ex) * 130 + p * 2], ai = AP[(d * 17 + ex) * 130 + p * 2 + 1];
                            v[e] = ri == 0 ? (cr * ar - ci * ai) : -(cr * ai + ci * ar); } }
                    u32x4 o; o.x = cvt_pk_bf16(v[0], v[1]); o.y = cvt_pk_bf16(v[2], v[3]); o.z = cvt_pk_bf16(v[4], v[5]); o.w = cvt_pk_bf16(v[6], v[7]);
                    *(u32x4*)(W2_t + ((size_t)g * 256 + n) * 512 + k0) = o;
                }
                for (int q = tid; q < 64 * 32; q += 512) {
                    const int n = part * 64 + (q >> 5), k0 = (q & 31) * 8, d = n >> 7, ri = (n >> 6) & 1, p = n & 63, i = k0 >> 4, c0 = k0 & 15, ex = d == 0 ? 15 - i : i;
                    const float ar = AP[(d * 17 + ex) * 130 + p * 2], ai = AP[(d * 17 + ex) * 130 + p * 2 + 1]; float v[8];
#pragma unroll
                    for (int e = 0; e < 8; ++e) { const float br = BB[((d * 64 + p) * 16 + c0 + e) * 2], bi = BB[((d * 64 + p) * 16 + c0 + e) * 2 + 1];
                        v[e] = ri == 0 ? (ar * br - ai * bi) : (ar * bi + ai * br); }
                    u32x4 o; o.x = cvt_pk_bf16(v[0], v[1]); o.y = cvt_pk_bf16(v[2], v[3]); o.z = cvt_pk_bf16(v[4], v[5]); o.w = cvt_pk_bf16(v[6], v[7]);
                    *(u32x4*)(W1_t + ((size_t)g * 256 + n) * 256 + k0) = o;
                }
                __syncthreads();
                continue;
            }
            it -= Q_S5;
            if (it < Q_WPB) {
                const float* pool_w = AIN(19); const float* pool_scale = AIN(20); const float* wb = AIN(22);
                const int j = it >> 4, n0 = (it & 15) * 64;
                LAS float* pw = fl; LAS float* wbs = fl + 128 * 128;
#pragma unroll
                for (int i = 0; i < 8; ++i) { const int idx = tid + 512 * i; *(LAS f32x4*)(pw + idx * 4) = *(const f32x4*)(pool_w + (size_t)j * 16384 + idx * 4); }
#pragma unroll
                for (int i = 0; i < 4; ++i) { const int idx = tid + 512 * i, q = idx >> 4, n4 = idx & 15;
                    *(LAS f32x4*)(wbs + q * 64 + n4 * 4) = *(const f32x4*)(wb + (size_t)(j * 128 + q) * 1024 + n0 + n4 * 4) * pool_scale[j * 128 + q]; }
                __syncthreads();
                const int n = tid & 63, kg = tid >> 6;
                float accp[16];
#pragma unroll
                for (int i = 0; i < 16; ++i) accp[i] = 0.f;
                for (int q4 = 0; q4 < 32; ++q4) { float wv[4];
#pragma unroll
                    for (int t = 0; t < 4; ++t) wv[t] = wbs[(4 * q4 + t) * 64 + n];
#pragma unroll
                    for (int i = 0; i < 16; ++i) { const f32x4 pv = *(const LAS f32x4*)(pw + (kg * 16 + i) * 128 + 4 * q4); accp[i] += (pv.x * wv[0] + pv.y * wv[1]) + (pv.z * wv[2] + pv.w * wv[3]); } }
                u32x4 o0, o1;
                o0.x = cvt_pk_bf16(accp[0], accp[1]); o0.y = cvt_pk_bf16(accp[2], accp[3]); o0.z = cvt_pk_bf16(accp[4], accp[5]); o0.w = cvt_pk_bf16(accp[6], accp[7]);
                o1.x = cvt_pk_bf16(accp[8], accp[9]); o1.y = cvt_pk_bf16(accp[10], accp[11]); o1.z = cvt_pk_bf16(accp[12], accp[13]); o1.w = cvt_pk_bf16(accp[14], accp[15]);
                bf16_t* dst = Wcat_t + (size_t)(n0 + n) * 1024 + 512 + j * 128 + kg * 16;
                *(u32x4*)dst = o0; *(u32x4*)(dst + 8) = o1;
                __syncthreads();
                continue;
            }
            it -= Q_WPB;
            if (it < Q_GEMV) {
                if (rep_ == 0) {
                const float* cvec = AIN(1); const float* cctx = AIN(3); const float* w_mod = AIN(4); const float* b_mod = AIN(5);
                const int col0 = (it & 63) * 96, kq = it >> 6, kbase = kq * 256;
                for (int i = tid; i < 768; i += 512) { const int which = i >> 8, kk = i & 255;
                    const float v = which == 0 ? cvec[kbase + kk] : which == 1 ? cvec[1024 + kbase + kk] : cctx[kbase + kk]; fl[i] = v * sigmoidf_(v); }
                __syncthreads();
                if (tid < 384) { const int kg = tid / 24, cq = tid % 24;
                    f32x4 a0 = {0.f, 0.f, 0.f, 0.f}, a1 = a0, a2 = a0;
#pragma unroll
                    for (int i = 0; i < 16; ++i) { const int kk = kg + 16 * i; const f32x4 w = ld_nt(w_mod + (size_t)(kbase + kk) * 6144 + col0 + cq * 4);
                        a0 += w * fl[kk]; a1 += w * fl[256 + kk]; a2 += w * fl[512 + kk]; }
                    LAS float* r = fl + 768 + (kg * 24 + cq) * 12;
                    *(LAS f32x4*)r = a0; *(LAS f32x4*)(r + 4) = a1; *(LAS f32x4*)(r + 8) = a2; }
                __syncthreads();
                if (tid < 288) { const int which = tid / 96, c = tid % 96, col = col0 + c; float sacc = 0.f;
#pragma unroll
                    for (int q = 0; q < 16; ++q) sacc += fl[768 + (q * 24 + (c >> 2)) * 12 + which * 4 + (c & 3)];
                    if (kq == 0) sacc += b_mod[col];
                    if (which < 2) atomicAdd(modx + which * 6144 + col, sacc); else if (col < 2048) atomicAdd(modc + col, sacc); }
                asm volatile("s_waitcnt vmcnt(0)" ::: "memory");
                __syncthreads();
                if (tid == 0) __hip_atomic_fetch_add(gemv_done, 1u, __ATOMIC_RELAXED, __HIP_MEMORY_SCOPE_AGENT);
                }
                continue;
            }
            it -= Q_GEMV;
            if (it < I_COPY) { copy_item(it, lds, ws, tid); continue; }
            it -= I_COPY;
            {
                if (!mod_ready) {
                    if (tid == 0) { unsigned sp = 0; while (__hip_atomic_load(gemv_done, __ATOMIC_RELAXED, __HIP_MEMORY_SCOPE_AGENT) < (unsigned)Q_GEMV) { __builtin_amdgcn_s_sleep(2); if (++sp > (1u << 22)) break; }
                        __builtin_amdgcn_fence(__ATOMIC_ACQUIRE, "agent"); asm volatile("s_waitcnt vmcnt(0)" ::: "memory"); }
                    __syncthreads(); mod_ready = true;
                }
                const float* x = AIN(0); const float* ctx = AIN(2); const float* norm1_g = AIN(6);
                for (int hb = 0; hb < 2; ++hb) {
                const int m0 = it * 64 + wave * 8 + hb * 4; const bool lat = m0 < MTOK;
                const float* src = lat ? x + (size_t)m0 * DM : ctx + (size_t)(m0 - MTOK) * DM;
                const float* shp = lat ? modx + (m0 >> 13) * 6144 : modc; const float* scp = shp + 1024;
                f32x4 v[4][4]; float ss[4];
#pragma unroll
                for (int r = 0; r < 4; ++r) { ss[r] = 0.f;
#pragma unroll
                    for (int j = 0; j < 4; ++j) v[r][j] = ld_nt(src + (size_t)r * DM + 4 * (lane + 64 * j)); }
#pragma unroll
                for (int r = 0; r < 4; ++r) {
#pragma unroll
                    for (int j = 0; j < 4; ++j) ss[r] += (v[r][j].x * v[r][j].x + v[r][j].y * v[r][j].y) + (v[r][j].z * v[r][j].z + v[r][j].w * v[r][j].w);
                    const float rstd = __builtin_amdgcn_rsqf(wave_sum(ss[r]) * (1.0f / DM) + RMS_EPS);
                    bf16_t* orow = H + (size_t)(m0 + r) * DM;
#pragma unroll
                    for (int j = 0; j < 4; ++j) { const int ci = lane + 64 * j; const f32x4 g = ((const f32x4*)norm1_g)[ci], a = ((const f32x4*)scp)[ci], b = ((const f32x4*)shp)[ci];
                        const f32x4 h = (v[r][j] * rstd * g) * (a + 1.0f) + b;
                        u32x2 o; o.x = cvt_pk_bf16(h.x, h.y); o.y = cvt_pk_bf16(h.z, h.w); ((u32x2*)orow)[ci] = o; } }
                }
            }
        }
    }
    GRID_BAR();
    }

    {
      const bool inS = !teams || bid < NS; const int CG = teams ? NS : G;
      {
        {
          unsigned char* ws = AWS(); pg8::ListOrder S; S.A = H; S.Bt = Win_t; S.lda = DM; S.ldb = DM; S.stride = 1; S.n = 0; S.L0 = 0; S.mode = 1;
          if (!teams) { S.L0 = bid; S.stride = G; S.n = bid < 792 ? (792 - bid + G - 1) / G : 0; S.mode = 2; }
          else if (bid < NS) { S.L0 = bid; S.n = bid < 132 ? 1 : 0; S.mode = 0; }
          else { S.L0 = bid - NS; S.n = 5; S.mode = 3; }
          pg8::EpiProj E{UG, PROJ};
          pg8::gemm_phase(lds, pg8::Gemm{DM, DM, DM}, S, E);
        }
        if (inS) {
          if (teams && bid >= 132) late_copies(5, lds, AWS());
          xcd_barrier(tbar);
          { unsigned char* ws = AWS(); pg8::GroupOrder S; S.init(UG, W1_t, UG_LD, 256, NCHP / 256, CG, bid); pg8::EpiE E{AOUT()};
            pg8::gemm_phase(lds, pg8::Gemm{256, UG_LD, 256}, S, E); }
          xcd_barrier(tbar);
    { PHASE_IDS(); unsigned char* ws = AWS(); const float* Ebuf = AOUT();
      LAS float* sx = (LAS float*)lds;
      for (int task = bid; task < 128; task += CG) {
        const int b = task >> 6, dir = (task >> 5) & 1, g = task & 31, p = lane;
        const float aTr = ATg[((g * 2 + dir) * 64 + p) * 2], aTi = ATg[((g * 2 + dir) * 64 + p) * 2 + 1];
        const float* Eg = Ebuf + (size_t)g * NCHP * 256 + dir * 128 + p;
        float er[64], ei[64];
        const int r0 = b * 512 + (dir ? 511 - wave * 64 : wave * 64); const long estep = dir ? -256 : 256, ustep = dir ? -UG_LD : UG_LD;
        { const float* ep = Eg + (size_t)r0 * 256;
#pragma unroll
          for (int i = 0; i < 64; ++i) { er[i] = ep[0]; ei[i] = ep[64]; ep += estep; } }
        if (wave == 0) {
            float cr[16], ci[16]; float sr = 0.f, si = 0.f;
#pragma unroll
            for (int i = 0; i < 16; ++i) { const int r = 1024 + b * 16 + (dir ? 15 - i : i); cr[i] = Eg[(size_t)r * 256]; ci[i] = Eg[(size_t)r * 256 + 64]; }
#pragma unroll
            for (int i = 0; i < 16; ++i) { const float nr = aTr * sr - aTi * si + cr[i], ni = aTr * si + aTi * sr + ci[i]; sr = nr; si = ni; }
            sx[(8 * 2 + 0) * 64 + p] = sr; sx[(8 * 2 + 1) * 64 + p] = si;
        }
        { float sr = 0.f, si = 0.f;
#pragma unroll
          for (int i = 0; i < 64; ++i) { const float nr = aTr * sr - aTi * si + er[i], ni = aTr * si + aTi * sr + ei[i]; sr = nr; si = ni; }
          sx[(wave * 2 + 0) * 64 + p] = sr; sx[(wave * 2 + 1) * 64 + p] = si; }
        __syncthreads();
        float sr = sx[(8 * 2 + 0) * 64 + p], si = sx[(8 * 2 + 1) * 64 + p];
        { float qr = aTr, qi = aTi;
#pragma unroll
          for (int k = 0; k < 6; ++k) { const float nr = qr * qr - qi * qi, ni = 2.0f * qr * qi; qr = nr; qi = ni; }
          for (int k = 0; k < wave; ++k) { const float tr = sx[(k * 2 + 0) * 64 + p], ti = sx[(k * 2 + 1) * 64 + p];
              const float nr = qr * sr - qi * si + tr, ni = qr * si + qi * sr + ti; sr = nr; si = ni; } }
        bf16_t* up = UG + (size_t)g * NCHP * UG_LD + 256 + dir * 128 + p + (size_t)r0 * UG_LD;
#pragma unroll
        for (int i = 0; i < 64; ++i) {
            const unsigned pk = cvt_pk_bf16(sr, si);
            up[0] = (bf16_t)(pk & 0xffffu); up[64] = (bf16_t)(pk >> 16); up += ustep;
            const float nr = aTr * sr - aTi * si + er[i], ni = aTr * si + aTi * sr + ei[i]; sr = nr; si = ni; }
        __syncthreads();
      } }
          if (teams && bid >= 128) late_copies(2, lds, AWS());
          xcd_barrier(tbar);
          if (teams && bid >= 128) late_copies(6, lds, AWS());
          { unsigned char* ws = AWS(); pg8::GroupOrder S; S.init(UG, W2_t, UG_LD, 512, MTOK / 16 / 256, CG, bid); pg8::EpiY E{Y};
            pg8::gemm_phase(lds, pg8::Gemm{512, UG_LD, 512}, S, E); }
        }
        if (teams && bid < NS) {
          unsigned char* ws = AWS(); pg8::ListOrder S; S.A = H; S.Bt = Win_t; S.lda = DM; S.ldb = DM; S.stride = 1; S.n = 1; S.L0 = bid; S.mode = 4;
          pg8::EpiProj E{UG, PROJ};
          pg8::gemm_phase(lds, pg8::Gemm{DM, DM, DM}, S, E);
        }
      }
    }
    GRID_BAR();

    _Pragma("unroll") for (int rep_ = 0; rep_ < (int)((DUP_MASK >> 6) & 1u) + 1; ++rep_) {
    { unsigned char* ws = AWS(); pg8::StaticOrder S; S.init(Y, Wglu_t, DS, DS, MTOK, DS, G, bid); pg8::EpiGlu E{Y, ZD, AIN(18)};
      pg8::gemm_phase(lds, pg8::Gemm{DS, DS, DS}, S, E); }
    { const int nidle = G - 128; const bool split = nidle >= 64;
      for (int s = split ? bid - 128 : bid; s >= 0 && s < 256; s += split ? nidle : G) {
        PHASE_IDS(); unsigned char* ws = AWS();
        LAS bf16_t* slab = (LAS bf16_t*)lds;
        const size_t tok0 = (size_t)s * 64;
        __syncthreads();
#pragma unroll
        for (int i = 0; i < 8; ++i) { const int q = tid + 512 * i, row = q >> 6, cc = q & 63;
            *(LAS u32x4*)(slab + row * 512 + cc * 8) = *(const u32x4*)(PROJ + (tok0 + row) * PROJ_LD + cc * 8); }
        __syncthreads();
        { const int j = wave >> 1; LAS bf16_t* col = slab + tid;
          if (j == 0) pool_column<2>(col); else if (j == 1) pool_column<4>(col); else if (j == 2) pool_column<8>(col); else pool_column<16>(col); }
        __syncthreads();
#pragma unroll
        for (int i = 0; i < 8; ++i) { const int q = tid + 512 * i, row = q >> 6, cc = q & 63;
            *(u32x4*)(ZD + (tok0 + row) * DM + 512 + cc * 8) = *(const LAS u32x4*)(slab + row * 512 + cc * 8); }
      } }
    if (teams && bid >= 128) late_copies(2, lds, AWS());
    { PHASE_IDS(); unsigned char* ws = AWS();
      const bool split = G >= 192; const int gw = (split ? bid - 128 : bid) * 8 + wave, NGW = (split ? G - 128 : G) * 8;
      for (int r = gw; r >= 0 && r < 2 * FF; r += NGW) {
        const u32x4* wrow = (const u32x4*)(Wffi_t + (size_t)r * DM) + lane * 2; f32x4 w0, w1, w2, w3; pg8::unpack8(wrow[0], w0, w1); pg8::unpack8(wrow[1], w2, w3);
        float sb[2];
#pragma unroll
        for (int b = 0; b < 2; ++b) { const f32x4* sp = (const f32x4*)(modx + b * 6144 + 3072) + lane * 4; const f32x4 a0 = sp[0] * w0, a1 = sp[1] * w1, a2 = sp[2] * w2, a3 = sp[3] * w3;
            sb[b] = wave_sum(((a0.x + a0.y) + (a0.z + a0.w)) + ((a1.x + a1.y) + (a1.z + a1.w)) + ((a2.x + a2.y) + (a2.z + a2.w)) + ((a3.x + a3.y) + (a3.z + a3.w))); }
        if (lane == 0) { BIAS2[r] = sb[0]; BIAS2[2 * FF + r] = sb[1]; }
      } }
    GRID_BAR();
    }

    _Pragma("unroll") for (int rep_ = 0; rep_ < (int)((DUP_MASK >> 7) & 1u) + 1; ++rep_) {
    { unsigned char* ws = AWS(); pg8::StaticOrder S; S.init(ZD, Wcat_t, DM, DM, MTOK, DM, G, bid); pg8::EpiMerged E{PROJ + 512, H};
      pg8::gemm_phase(lds, pg8::Gemm{DM, DM, DM}, S, E); }
    GRID_BAR();
    }

    { unsigned char* ws = AWS(); pg8::StaticOrder S; S.init(H, Wout_t, DM, DM, MTOK, DM, G, bid); pg8::EpiResidNorm E{AIN(0), AOUT(), modx, AIN(7), H2, ROWSS4, (LAS float*)(lds + MISC_OFF + 512)};
      pg8::gemm_phase(lds, pg8::Gemm{DM, DM, DM}, S, E); }
    GRID_BAR();

    _Pragma("unroll") for (int rep_ = 0; rep_ < (int)((DUP_MASK >> 10) & 1u) + 1; ++rep_) {
    { unsigned char* ws = AWS(); pg8::StaticOrder S; S.init(H2, Wffi_t, DM, DM, MTOK, 2 * FF, G, bid); pg8::EpiSwigluN E{AFFN, ROWSS4, BIAS2};
      pg8::gemm_phase(lds, pg8::Gemm{DM, DM, DM}, S, E); }
    GRID_BAR();
    }

    if (G == 256) {
      unsigned char* ws = AWS(); float* out = AOUT(); pg8::StaticOrder S; S.init(AFFN, Wffo_t, FF, FF, MTOK, DM, G, bid); pg8::EpiResidFinal E{out, modx + 5120, AIN(26), ROWSS2, PCNT};
      pg8::gemm_phase(lds, pg8::Gemm{FF, FF, FF}, S, E);
    } else {
      { unsigned char* ws = AWS(); float* out = AOUT(); pg8::StaticOrder S; S.init(AFFN, Wffo_t, FF, FF, MTOK, DM, G, bid); pg8::EpiResid E{out, out, modx + 5120};
        pg8::gemm_phase(lds, pg8::Gemm{FF, FF, FF}, S, E); }
      GRID_BAR();
      { const float* fg = AIN(26); float* out = AOUT(); PHASE_IDS();
        for (int m = bid * 8 + wave; m < MTOK; m += G * 8) {
          float* row = out + (size_t)m * DM; f32x4 v[4]; float s = 0.f;
#pragma unroll
          for (int j = 0; j < 4; ++j) { v[j] = ((const f32x4*)row)[lane + 64 * j]; s += (v[j].x * v[j].x + v[j].y * v[j].y) + (v[j].z * v[j].z + v[j].w * v[j].w); }
          const float rstd = __builtin_amdgcn_rsqf(wave_sum(s) * (1.0f / DM) + RMS_EPS);
#pragma unroll
          for (int j = 0; j < 4; ++j) ((f32x4*)row)[lane + 64 * j] = v[j] * rstd * ((const f32x4*)fg)[lane + 64 * j];
        } }
    }
}

extern "C" void kernel_launch(void* const* d_in, const int* in_sizes, int n_in, void* d_out, int out_size, void* d_ws, size_t ws_size, hipStream_t stream) {
    static int grid = 0;
    if (grid == 0) {
        int dev = 0, cus = 0, per_cu = 0;
        if (n_in != 27 || ws_size < WS_END || out_size != MTOK * DM) { fprintf(stderr, "kernel_launch: unexpected sizes (n_in %d, ws %zu, out %d)\n", n_in, ws_size, out_size); grid = -1; return; }
        if (hipGetDevice(&dev) != hipSuccess || hipDeviceGetAttribute(&cus, hipDeviceAttributeMultiprocessorCount, dev) != hipSuccess) { grid = -1; return; }
        if (hipFuncSetAttribute((const void*)mega_fwd, hipFuncAttributeMaxDynamicSharedMemorySize, LDS_BYTES) != hipSuccess) { fprintf(stderr, "kernel_launch: hipFuncSetAttribute failed\n"); grid = -1; return; }
        if (hipOccupancyMaxActiveBlocksPerMultiprocessor(&per_cu, (const void*)mega_fwd, 512, LDS_BYTES) != hipSuccess || per_cu < 1) { fprintf(stderr, "kernel_launch: occupancy query failed (%d)\n", per_cu); (void)hipGetLastError(); per_cu = 1; }
        grid = cus * per_cu;
    }
    if (grid < 0) return;
    (void)hipMemsetAsync((char*)d_ws + WS_CTL + 16384, 0, CTL_BYTES - 16384, stream);
    Args a{};
    for (int i = 0; i < 27; ++i) a.in[i] = (const float*)d_in[i];
    a.out = (float*)d_out; a.ws = (unsigned char*)d_ws;
    void* kargs[] = {&a};
    hipError_t e = hipLaunchCooperativeKernel((const void*)mega_fwd, dim3(grid), dim3(512), kargs, LDS_BYTES, stream);
    if (e != hipSuccess) fprintf(stderr, "kernel_launch: cooperative launch failed: %s (grid %d)\n", hipGetErrorString(e), grid);
}
```
